# Optimizing an MI355X kernel written in HIP

```python
import math
import jax
import jax.numpy as jnp
from jax import lax
import numpy as np

D_MODEL = 1024
BATCH = 8
SEQ = 4096
DEPTH = 2

N_EVEN = (DEPTH + 1) // 2
N_ODD = DEPTH // 2
EPS = 1e-6
CONV_W = 3

HG_HEADS = 4
HG_DK = 128
HG_DV = 128
HG_WIDTH = HG_HEADS * HG_DK
HG_CHUNK = 64
SC_WIDTH = D_MODEL - HG_WIDTH
SC_GROUPS = 8
AB_SIZES = (HG_WIDTH,) * 4 + (SC_WIDTH,) * 3
AB_IN = sum(AB_SIZES)

NSA_HEADS = 16
NSA_KV = 4
NSA_HPG = NSA_HEADS // NSA_KV
NSA_DH = D_MODEL // NSA_HEADS
CMP_LEN = 32
CMP_STRIDE = 16
CMP_HIDDEN = 256
SEL_BLOCK = 64
SEL_TOPN = 16
WINDOW = 512
NSA_QB = 64
NSA_SIZES = (NSA_HEADS * NSA_DH, 3 * NSA_HEADS) + (NSA_KV * NSA_DH,) * 6
NSA_IN = sum(NSA_SIZES)

REL_BUCKETS = 32
REL_MAX_DIST = 1024

D_FF = 2816

kernel_name = 'hybrid_hgrn2_shortconv_nsa_convffn_adaln'


def split_cols(a, sizes):
    return jnp.split(a, [int(v) for v in np.cumsum(sizes)[:-1]], axis=-1)


def rmsnorm(x, g):
    xf = x.astype(jnp.float32)
    y = xf * lax.rsqrt(jnp.mean(xf * xf, axis=-1, keepdims=True) + EPS)
    return (y * g.astype(jnp.float32)).astype(x.dtype)


def causal_dwconv3(u, w):
    S = u.shape[1]
    up = jnp.pad(u, ((0, 0), (CONV_W - 1, 0), (0, 0)))
    return up[:, 0:S] * w[0] + up[:, 1:S + 1] * w[1] + up[:, 2:S + 2] * w[2]


def rel_bucket(dist):
    n = jnp.maximum(dist, 0)
    exact = REL_BUCKETS // 2
    large = exact + (jnp.log(jnp.maximum(n, exact).astype(jnp.float32) / exact)
                     / math.log(REL_MAX_DIST / exact) * (REL_BUCKETS - exact)).astype(jnp.int32)
    return jnp.where(n < exact, n, jnp.minimum(large, REL_BUCKETS - 1))


def masked_softmax(logits, mask):
    logits = jnp.where(mask, logits.astype(jnp.float32), -jnp.inf)
    m = jnp.max(logits, axis=-1, keepdims=True)
    m = jnp.where(jnp.isfinite(m), m, 0.0)
    e = jnp.exp(logits - m)
    den = jnp.sum(e, axis=-1, keepdims=True)
    return e / jnp.where(den > 0, den, 1.0)


def hgrn2_chunked(q, k, v, log_f):
    f32 = jnp.float32
    q, k, v, log_f = (a.astype(f32) for a in (q, k, v, log_f))
    B, H, S, K = q.shape
    V = v.shape[-1]
    C = HG_CHUNK
    NC = S // C

    def to_chunks(a):
        return jnp.moveaxis(a.reshape(B, H, NC, C, a.shape[-1]), 2, 0)

    causal = jnp.tril(jnp.ones((C, C), bool))[:, :, None]

    def step(state, inp):
        qi, ki, vi, gi = inp
        b = jnp.cumsum(gi, axis=2)
        diff = b[:, :, :, None, :] - b[:, :, None, :, :]
        decay = jnp.exp(jnp.where(causal, diff, -jnp.inf))
        attn = jnp.einsum('bhtk,bhsk,bhtsk->bhts', qi, ki, decay)
        o = (jnp.einsum('bhts,bhsv->bhtv', attn, vi)
             + jnp.einsum('bhtk,bhkv->bhtv', qi * jnp.exp(b), state))
        b_last = b[:, :, -1]
        state = (state * jnp.exp(b_last)[..., None]
                 + jnp.einsum('bhsk,bhsv->bhkv', ki * jnp.exp(b_last[:, :, None] - b), vi))
        return state, o

    state0 = jnp.zeros((B, H, K, V), f32)
    _, o = lax.scan(step, state0, (to_chunks(q), to_chunks(k), to_chunks(v), to_chunks(log_f)))
    return jnp.moveaxis(o, 0, 2).reshape(B, H, S, V)


def mixer_hgrn2_shortconv(h, w_in, w_out, lower_bound, onorm_g, sconv_w):
    B, S, _ = h.shape
    f32 = jnp.float32
    q, f, i, g, gb, gc, sv = split_cols(h @ w_in, AB_SIZES)
    lb = lower_bound.astype(f32)
    fgate = lb + (1.0 - lb) * jax.nn.sigmoid(f.astype(f32))

    def heads(a):
        return a.reshape(B, S, HG_HEADS, -1).transpose(0, 2, 1, 3)

    o = hgrn2_chunked(heads(q), heads(1.0 - fgate), heads(i), heads(jnp.log(fgate)))
    o = rmsnorm(o, onorm_g).transpose(0, 2, 1, 3).reshape(B, S, HG_WIDTH)
    o_a = (o * jax.nn.silu(g.astype(f32))).astype(h.dtype)
    o_b = gb * causal_dwconv3(gc * sv, sconv_w)
    return jnp.concatenate([o_a, o_b.astype(h.dtype)], axis=-1) @ w_out


def mixer_nsa(h, w_in, w_out, pos_k, pos_v, w1_k, w2_k, w1_v, w2_v, rel_bias):
    B, S, _ = h.shape
    f32 = jnp.float32
    q, gl, kc, vc, ks, vs, kw, vw = split_cols(h @ w_in, NSA_SIZES)
    q = q.reshape(B, S, NSA_KV, NSA_HPG, NSA_DH).transpose(0, 2, 3, 1, 4) * (NSA_DH ** -0.5)
    gates = jax.nn.sigmoid(gl.astype(f32)).reshape(B, S, 3, NSA_KV, NSA_HPG).transpose(2, 0, 3, 4, 1)

    def kvh(a):
        return a.reshape(B, S, NSA_KV, NSA_DH).transpose(0, 2, 1, 3)

    kc, vc, ks, vs, kw, vw = (kvh(a) for a in (kc, vc, ks, vs, kw, vw))

    n_cmp = (S - CMP_LEN) // CMP_STRIDE + 1
    cmp_idx = np.arange(n_cmp)[:, None] * CMP_STRIDE + np.arange(CMP_LEN)[None, :]
    cmp_end = jnp.asarray(cmp_idx[:, -1], jnp.int32)

    def compress(a, pos, w1, w2):
        blocks = (a[:, :, cmp_idx] + pos).reshape(B, NSA_KV, n_cmp, CMP_LEN * NSA_DH)
        return jax.nn.silu(blocks @ w1) @ w2

    k_cmp = compress(kc, pos_k, w1_k, w2_k)
    v_cmp = compress(vc, pos_v, w1_v, w2_v).astype(f32)

    n_sel = S // SEL_BLOCK
    n_top = min(SEL_TOPN, n_sel)
    c_start = np.arange(n_cmp)[:, None] * CMP_STRIDE
    s_start = np.arange(n_sel)[None, :] * SEL_BLOCK
    inside = np.clip(np.minimum(c_start + CMP_LEN, s_start + SEL_BLOCK) - np.maximum(c_start, s_start), 0, None)
    cmp_to_sel = jnp.asarray(inside / CMP_LEN, f32)
    blk = jnp.arange(n_sel)

    kw_pad = jnp.pad(kw, ((0, 0), (0, 0), (WINDOW, 0), (0, 0)))
    vw_pad = jnp.pad(vw, ((0, 0), (0, 0), (WINDOW, 0), (0, 0)))
    rb = rel_bias.astype(f32)
    rb_grp = rb.reshape(REL_BUCKETS, NSA_KV, NSA_HPG)
    gather = jax.vmap(jax.vmap(lambda a, p: a[p]))

    def shared_bias(dist):
        return rb[rel_bucket(dist)].reshape(*dist.shape, NSA_KV, NSA_HPG).transpose(2, 3, 0, 1)

    def query_block(start):
        t = start + jnp.arange(NSA_QB)
        qb = lax.dynamic_slice_in_dim(q, start, NSA_QB, axis=3)
        gb = lax.dynamic_slice_in_dim(gates, start, NSA_QB, axis=4)[..., None]
        dist_c = t[:, None] - cmp_end[None, :]
        s_c = jnp.einsum('bgiqd,bgnd->bgiqn', qb, k_cmp).astype(f32) + shared_bias(dist_c)
        p_c = masked_softmax(s_c, dist_c >= 0)
        o_c = jnp.einsum('bgiqn,bgnd->bgiqd', p_c, v_cmp)
        imp = jnp.einsum('bgiqn,ns->bgqs', p_c, cmp_to_sel)
        cur = (t // SEL_BLOCK)[:, None]
        forced = (blk[None] == 0) | (blk[None] == cur) | (blk[None] == cur - 1)
        score = jnp.where(blk[None] > cur, -jnp.inf, jnp.where(forced, jnp.inf, imp))
        _, sel = lax.top_k(score, n_top)
        pos = (sel[..., None] * SEL_BLOCK + jnp.arange(SEL_BLOCK)).reshape(B, NSA_KV, NSA_QB, n_top * SEL_BLOCK)
        k_sel = gather(ks, pos)
        v_sel = gather(vs, pos).astype(f32)
        dist_s = t[:, None] - pos
        bias_s = jnp.moveaxis(rb_grp[rel_bucket(dist_s), jnp.arange(NSA_KV)[None, :, None, None]], -1, 2)
        s_s = jnp.einsum('bgiqd,bgqkd->bgiqk', qb, k_sel).astype(f32) + bias_s
        p_s = masked_softmax(s_s, (dist_s >= 0)[:, :, None])
        o_s = jnp.einsum('bgiqk,bgqkd->bgiqd', p_s, v_sel)
        kwb = lax.dynamic_slice_in_dim(kw_pad, start, WINDOW + NSA_QB, axis=2)
        vwb = lax.dynamic_slice_in_dim(vw_pad, start, WINDOW + NSA_QB, axis=2).astype(f32)
        wpos = start - WINDOW + jnp.arange(WINDOW + NSA_QB)
        dist_w = t[:, None] - wpos[None, :]
        mask_w = (dist_w >= 0) & (dist_w < WINDOW) & (wpos[None, :] >= 0)
        s_w = jnp.einsum('bgiqd,bgkd->bgiqk', qb, kwb).astype(f32) + shared_bias(dist_w)
        p_w = masked_softmax(s_w, mask_w)
        o_w = jnp.einsum('bgiqk,bgkd->bgiqd', p_w, vwb)
        return gb[0] * o_c + gb[1] * o_s + gb[2] * o_w

    starts = jnp.arange(S // NSA_QB, dtype=jnp.int32) * NSA_QB
    o = lax.map(query_block, starts)
    o = o.transpose(1, 0, 4, 2, 3, 5).reshape(B, S, NSA_HEADS * NSA_DH)
    return o.astype(h.dtype) @ w_out


def conv_ffn(h, w_up, conv_w, w_down):
    gate, up = jnp.split(h @ w_up, 2, axis=-1)
    return (jax.nn.silu(causal_dwconv3(gate, conv_w)) * up) @ w_down


def setup_inputs(seed: int = 0) -> dict:
    key = jax.random.key(seed)
    keys = iter(jax.random.split(key, 40))

    def nrm(shape, scale):
        return jax.random.normal(next(keys), shape, jnp.float32) * scale

    D = D_MODEL
    return {
        'x': nrm((BATCH, SEQ, D), 1.0),
        'c': nrm((BATCH, D), 1.0),
        'mod_w': nrm((DEPTH, D, 6 * D), 0.5 * D ** -0.5),
        'mod_b': nrm((DEPTH, 6 * D), 0.02),
        'norm_mix_g': 1.0 + nrm((DEPTH, D), 0.02),
        'norm_ffn_g': 1.0 + nrm((DEPTH, D), 0.02),
        'ab_w_in': nrm((N_EVEN, D, AB_IN), D ** -0.5),
        'ab_w_out': nrm((N_EVEN, HG_WIDTH + SC_WIDTH, D), (HG_WIDTH + SC_WIDTH) ** -0.5),
        'hgrn_lb_logits': nrm((N_EVEN + 1, HG_WIDTH), 0.1),
        'hgrn_onorm_g': 1.0 + nrm((N_EVEN, HG_DV), 0.02),
        'sconv_w': nrm((N_EVEN, CONV_W, SC_WIDTH), CONV_W ** -0.5),
        'nsa_w_in': nrm((N_ODD, D, NSA_IN), D ** -0.5),
        'nsa_w_out': nrm((N_ODD, NSA_HEADS * NSA_DH, D), (NSA_HEADS * NSA_DH) ** -0.5),
        'nsa_cmp_pos_k': nrm((N_ODD, CMP_LEN, NSA_DH), 0.02),
        'nsa_cmp_pos_v': nrm((N_ODD, CMP_LEN, NSA_DH), 0.02),
        'nsa_cmp_w1_k': nrm((N_ODD, CMP_LEN * NSA_DH, CMP_HIDDEN), (CMP_LEN * NSA_DH) ** -0.5),
        'nsa_cmp_w2_k': nrm((N_ODD, CMP_HIDDEN, NSA_DH), CMP_HIDDEN ** -0.5),
        'nsa_cmp_w1_v': nrm((N_ODD, CMP_LEN * NSA_DH, CMP_HIDDEN), (CMP_LEN * NSA_DH) ** -0.5),
        'nsa_cmp_w2_v': nrm((N_ODD, CMP_HIDDEN, NSA_DH), CMP_HIDDEN ** -0.5),
        'rel_bias': nrm((REL_BUCKETS, NSA_HEADS), 0.5),
        'ffn_w_up': nrm((DEPTH, D, 2 * D_FF), D ** -0.5),
        'ffn_conv_w': nrm((DEPTH, CONV_W, D_FF), CONV_W ** -0.5),
        'ffn_w_down': nrm((DEPTH, D_FF, D), D_FF ** -0.5),
        'final_norm_g': 1.0 + nrm((D,), 0.02),
    }


def reference(x, c, mod_w, mod_b, norm_mix_g, norm_ffn_g, ab_w_in, ab_w_out, hgrn_lb_logits,
              hgrn_onorm_g, sconv_w, nsa_w_in, nsa_w_out, nsa_cmp_pos_k, nsa_cmp_pos_v,
              nsa_cmp_w1_k, nsa_cmp_w2_k, nsa_cmp_w1_v, nsa_cmp_w2_v, rel_bias,
              ffn_w_up, ffn_conv_w, ffn_w_down, final_norm_g):
    lower = jnp.cumsum(jax.nn.softmax(hgrn_lb_logits.astype(jnp.float32), axis=0), axis=0)
    c_act = jax.nn.silu(c)
    for l in range(DEPTH):
        mod = c_act @ mod_w[l] + mod_b[l]
        sh1, sc1, g1, sh2, sc2, g2 = jnp.split(mod[:, None, :], 6, axis=-1)
        hm = rmsnorm(x, norm_mix_g[l]) * (1.0 + sc1) + sh1
        j = l // 2
        if l % 2 == 0:
            y = mixer_hgrn2_shortconv(hm, ab_w_in[j], ab_w_out[j], lower[j], hgrn_onorm_g[j], sconv_w[j])
        else:
            y = mixer_nsa(hm, nsa_w_in[j], nsa_w_out[j], nsa_cmp_pos_k[j], nsa_cmp_pos_v[j],
                          nsa_cmp_w1_k[j], nsa_cmp_w2_k[j], nsa_cmp_w1_v[j], nsa_cmp_w2_v[j], rel_bias)
        x = x + g1 * y
        hf = rmsnorm(x, norm_ffn_g[l]) * (1.0 + sc2) + sh2
        x = x + g2 * conv_ffn(hf, ffn_w_up[l], ffn_conv_w[l], ffn_w_down[l])
    return rmsnorm(x, final_norm_g)
```

```cpp
#include <hip/hip_runtime.h>
#include <hip/hip_cooperative_groups.h>
#include <cstdio>
#include <cstdint>
namespace cg = cooperative_groups;
namespace pg8 {
#define PG8_LAS __attribute__((address_space(3)))
typedef unsigned short bf16_t;
typedef short bf16x8 __attribute__((ext_vector_type(8)));
typedef float f32x4 __attribute__((ext_vector_type(4)));
typedef unsigned u32x4 __attribute__((ext_vector_type(4)));
constexpr int BM = 256, BK = 64, HALF = 128, HTB = HALF * BK * 2  , STAGE_BYTES = 8 * HTB, NXCD = 8, WGM = 8;

__host__ __device__ __forceinline__ int lds_byte(int r, int c) { const int st = (r >> 4) * 2 + (c >> 5), rr = r & 15, cc = c & 31, ob = rr * 64 + cc * 2; return st * 1024 + (ob ^ (((ob >> 9) & 1) << 5)); }
__host__ __device__ __forceinline__ void stage_rc(int b, int& R, int& C) { const int st = b / 1024, sb = b % 1024, swz = sb ^ (((sb >> 9) & 1) << 5); R = (st >> 1) * 16 + swz / 64; C = (st & 1) * 32 + (swz % 64) / 2; }
__host__ __device__ __forceinline__ int perm32(int rho) { const int n = rho >> 4, i = rho & 15; return 8 * (i >> 2) + 4 * n + (i & 3); }

struct Unit { int pm, pn; };
struct Gemm { const bf16_t* A; const bf16_t* Bt; int M, N, K, lda; };

struct StaticOrder {
    int nM, nN, nwg, G, c;
    __host__ __device__ void init(int M, int N, int G_, int c_) { nM = M / BM; nN = N / BM; nwg = nM * nN; G = G_; c = c_; }
    __host__ __device__ bool next(int i, Unit& u) const {
        const long L = (long)i * G + c; if (L >= nwg) return false;
        int wgid = (int)L; { const int q = nwg / NXCD, r = nwg % NXCD, xcd = wgid % NXCD, off = wgid / NXCD; wgid = (xcd < r ? xcd * (q + 1) : r * (q + 1) + (xcd - r) * q) + off; }
        const int nig = WGM * nN, gid = wgid / nig, fm = gid * WGM, gsz = (nM - fm) < WGM ? (nM - fm) : WGM;
        u.pm = fm + ((wgid % nig) % gsz); u.pn = (wgid % nig) / gsz; return true;
    }
    __device__ __forceinline__ void a_ready(const Unit&) const {}
    __device__ __forceinline__ void done(const Unit&) const {}
};

template <class Epi, class Sched, bool ALIGN_EPI = false, bool SP2 = false>
__device__ __forceinline__ void gemm_phase(PG8_LAS unsigned char* lds, const Gemm g, const Sched& S, const Epi& E, int tid_in) {
    const int tid = tid_in, wid = __builtin_amdgcn_readfirstlane(tid >> 6), lane = tid & 63, wr = wid >> 2, wc = wid & 3, fr = lane & 15, fq = lane >> 4;
    const int K = g.K, nt = K / BK;
    unsigned voffA[2], voffB[2];
#pragma unroll
    for (int i = 0; i < 2; ++i) { int R, C; stage_rc(tid * 16 + i * 8192, R, C); const int Rb = Epi::PERM ? ((R & ~31) + perm32(R & 31)) : R;
        voffA[i] = (unsigned)(R * g.lda + C) * 2u; voffB[i] = (unsigned)(Rb * K + C) * 2u; }
    const size_t kstep = (size_t)(BK * 2);
    const size_t hstepA = (size_t)HALF * g.lda * 2, hstepB = (size_t)HALF * K * 2;
    const size_t tstepA = 2 * hstepA, tstepB = 2 * hstepB;
    const unsigned ldsw = (unsigned)wid * 1024u;
    const int aoff = lds_byte(wr * 64 + fr, fq * 8), boff = lds_byte(wc * 32 + fr, fq * 8);
#define PG8_SA(b, h) (((b) * 2 + (h)) * HTB)
#define PG8_SB(b, h) ((4 + (b) * 2 + (h)) * HTB)
#define PG8_STAGE(bufoff, gbase, voff) do { _Pragma("unroll") for (int _i = 0; _i < 2; ++_i) \
        __builtin_amdgcn_global_load_lds((const unsigned*)((const char*)(gbase) + (voff)[_i]), (PG8_LAS unsigned*)(lds + (bufoff) + ldsw + _i * 8192), 16, 0, 0); } while (0)
#define PG8_LDA(dst, b, h) do { _Pragma("unroll") for (int m = 0; m < 4; ++m) _Pragma("unroll") for (int k = 0; k < 2; ++k) dst[m][k] = *(const PG8_LAS bf16x8*)(lds + PG8_SA(b, h) + aoff + m * 2048 + k * 1024); } while (0)
#define PG8_LDB(dst, b, h) do { _Pragma("unroll") for (int n = 0; n < 2; ++n) _Pragma("unroll") for (int k = 0; k < 2; ++k) dst[n][k] = *(const PG8_LAS bf16x8*)(lds + PG8_SB(b, h) + boff + n * 2048 + k * 1024); } while (0)
#define PG8_MMA(ai, bj, At, Bt) do { __builtin_amdgcn_s_setprio(1); _Pragma("unroll") for (int m = 0; m < 4; ++m) _Pragma("unroll") for (int n = 0; n < 2; ++n) _Pragma("unroll") for (int k = 0; k < 2; ++k) \
        acc[ai][bj][m][n] = __builtin_amdgcn_mfma_f32_16x16x32_bf16(Bt[n][k], At[m][k], acc[ai][bj][m][n], 0, 0, 0); __builtin_amdgcn_s_setprio(0); } while (0)
#define PG8_WAIT_V(n) asm volatile("s_waitcnt vmcnt(" #n ")" ::: "memory")
#define PG8_WAIT_L(n) asm volatile("s_waitcnt lgkmcnt(" #n ")" ::: "memory")
#define PG8_BAR __builtin_amdgcn_s_barrier()
#define PG8_SCHED __builtin_amdgcn_sched_barrier(0)
    Unit cur, nxt; int ui = 0;
    if (!S.next(0, cur)) return;
    f32x4 acc[2][2][4][2];
#pragma unroll
    for (int a = 0; a < 2; ++a)
#pragma unroll
        for (int b = 0; b < 2; ++b)
#pragma unroll
            for (int m = 0; m < 4; ++m)
#pragma unroll
                for (int n = 0; n < 2; ++n) acc[a][b][m][n] = (f32x4){0.f, 0.f, 0.f, 0.f};
    bf16x8 At[4][2], B0[2][2], B1[2][2];
    const char* cA = (const char*)g.A + (size_t)cur.pm * tstepA; const char* cB = (const char*)g.Bt + (size_t)cur.pn * tstepB;
    S.a_ready(cur);
    if constexpr (SP2) {
        PG8_STAGE(PG8_SB(0, 0), cB, voffB); PG8_STAGE(PG8_SB(0, 1), cB + hstepB, voffB); PG8_STAGE(PG8_SA(0, 0), cA, voffA); PG8_STAGE(PG8_SA(0, 1), cA + hstepA, voffA);
        if (wr == 1) PG8_BAR;
        PG8_WAIT_V(2); PG8_BAR;
        PG8_STAGE(PG8_SB(1, 0), cB + kstep, voffB); PG8_STAGE(PG8_SA(1, 0), cA + kstep, voffA); PG8_STAGE(PG8_SB(1, 1), cB + hstepB + kstep, voffB);
        PG8_WAIT_V(6); PG8_BAR;
    } else {
        PG8_STAGE(PG8_SB(0, 0), cB, voffB); PG8_STAGE(PG8_SA(0, 0), cA, voffA); PG8_STAGE(PG8_SB(0, 1), cB + hstepB, voffB); PG8_STAGE(PG8_SA(0, 1), cA + hstepA, voffA);
        if (wr == 1) PG8_BAR;
        PG8_WAIT_V(4); PG8_BAR;
        PG8_STAGE(PG8_SB(1, 0), cB + kstep, voffB); PG8_STAGE(PG8_SA(1, 0), cA + kstep, voffA); PG8_STAGE(PG8_SB(1, 1), cB + hstepB + kstep, voffB);
        PG8_WAIT_V(6); PG8_BAR;
    }
    for (;;) {
        const bool has_next = S.next(ui + 1, nxt);
        const char* nA = has_next ? (const char*)g.A + (size_t)nxt.pm * tstepA : cA; const char* nB = has_next ? (const char*)g.Bt + (size_t)nxt.pn * tstepB : cB;
        for (int t = 0; t < nt; t += 2) {
            const bool last = (t == nt - 2);
            const char* a1 = cA + (size_t)(t + 1) * kstep;
            const char* a2 = last ? nA : cA + (size_t)(t + 2) * kstep; const char* b2 = last ? nB : cB + (size_t)(t + 2) * kstep;
            const char* a3 = a2 + kstep; const char* b3 = b2 + kstep;
            if (last && has_next) S.a_ready(nxt);
            if constexpr (SP2) {
            PG8_LDB(B0, 0, 0); PG8_LDB(B1, 0, 1); PG8_SCHED; PG8_LDA(At, 0, 0); PG8_STAGE(PG8_SA(1, 1), a1 + hstepA, voffA);
            PG8_WAIT_V(8); PG8_WAIT_L(0); PG8_BAR; PG8_MMA(0, 0, At, B0); PG8_MMA(0, 1, At, B1); PG8_BAR; PG8_SCHED;
            PG8_LDA(At, 0, 1); PG8_STAGE(PG8_SB(0, 0), b2, voffB); PG8_STAGE(PG8_SB(0, 1), b2 + hstepB, voffB); PG8_STAGE(PG8_SA(0, 0), a2, voffA);
            PG8_WAIT_V(8); PG8_WAIT_L(0); PG8_BAR; PG8_MMA(1, 0, At, B0); PG8_MMA(1, 1, At, B1); PG8_BAR; PG8_SCHED;
            PG8_LDB(B0, 1, 0); PG8_LDB(B1, 1, 1); PG8_SCHED; PG8_LDA(At, 1, 0); PG8_STAGE(PG8_SA(0, 1), a2 + hstepA, voffA);
            PG8_WAIT_V(8); PG8_WAIT_L(0); PG8_BAR; PG8_MMA(0, 0, At, B0); PG8_MMA(0, 1, At, B1); PG8_BAR; PG8_SCHED;
            PG8_LDA(At, 1, 1); PG8_STAGE(PG8_SB(1, 0), b3, voffB); PG8_STAGE(PG8_SB(1, 1), b3 + hstepB, voffB); PG8_STAGE(PG8_SA(1, 0), a3, voffA);
            PG8_WAIT_V(8); PG8_WAIT_L(0); PG8_BAR; PG8_MMA(1, 0, At, B0); PG8_MMA(1, 1, At, B1); PG8_BAR; PG8_SCHED;
            } else {
            PG8_LDB(B0, 0, 0); PG8_SCHED; PG8_LDA(At, 0, 0); PG8_STAGE(PG8_SA(1, 1), a1 + hstepA, voffA);
            PG8_WAIT_L(8); PG8_BAR; PG8_WAIT_L(0); PG8_MMA(0, 0, At, B0); PG8_BAR; PG8_SCHED;
            PG8_LDB(B1, 0, 1); PG8_STAGE(PG8_SB(0, 0), b2, voffB);
            PG8_BAR; PG8_WAIT_L(0); PG8_MMA(0, 1, At, B1); PG8_BAR;
            PG8_LDA(At, 0, 1); PG8_STAGE(PG8_SA(0, 0), a2, voffA);
            PG8_BAR; PG8_WAIT_L(0); PG8_MMA(1, 0, At, B0); PG8_BAR; PG8_SCHED;
            PG8_STAGE(PG8_SB(0, 1), b2 + hstepB, voffB);
            PG8_WAIT_V(6); PG8_BAR; PG8_MMA(1, 1, At, B1); PG8_BAR;
            PG8_LDB(B0, 1, 0); PG8_SCHED; PG8_LDA(At, 1, 0); PG8_STAGE(PG8_SA(0, 1), a2 + hstepA, voffA);
            PG8_WAIT_L(8); PG8_BAR; PG8_WAIT_L(0); PG8_MMA(0, 0, At, B0); PG8_BAR; PG8_SCHED;
            PG8_LDB(B1, 1, 1); PG8_STAGE(PG8_SB(1, 0), b3, voffB);
            PG8_BAR; PG8_WAIT_L(0); PG8_MMA(0, 1, At, B1); PG8_BAR;
            PG8_LDA(At, 1, 1); PG8_STAGE(PG8_SA(1, 0), a3, voffA);
            PG8_BAR; PG8_WAIT_L(0); PG8_MMA(1, 0, At, B0); PG8_BAR; PG8_SCHED;
            PG8_STAGE(PG8_SB(1, 1), b3 + hstepB, voffB);
            PG8_WAIT_V(6); PG8_BAR; PG8_MMA(1, 1, At, B1); PG8_BAR;
            }
        }
        if constexpr (ALIGN_EPI) { if (wr == 0) PG8_BAR; }
        if constexpr (!Epi::AFTER_DRAIN) { E(acc, cur, wr, wc, fr, fq); S.done(cur); }
        if (!has_next) break;
#pragma unroll
        for (int a = 0; a < 2; ++a)
#pragma unroll
            for (int b = 0; b < 2; ++b)
#pragma unroll
                for (int m = 0; m < 4; ++m)
#pragma unroll
                    for (int n = 0; n < 2; ++n) acc[a][b][m][n] = (f32x4){0.f, 0.f, 0.f, 0.f};
        cur = nxt; cA = nA; cB = nB; ++ui;
        if constexpr (ALIGN_EPI) { if (wr == 1) PG8_BAR; }
    }
    PG8_WAIT_V(0);
    if constexpr (!ALIGN_EPI) { if (wr == 0) PG8_BAR; }
    PG8_BAR;
    if constexpr (Epi::AFTER_DRAIN) { E.fused(acc, cur, wr, wc, fr, fq, lds, wid, lane); S.done(cur); }
#undef PG8_SA
#undef PG8_SB
#undef PG8_STAGE
#undef PG8_LDA
#undef PG8_LDB
#undef PG8_MMA
#undef PG8_WAIT_V
#undef PG8_WAIT_L
#undef PG8_BAR
#undef PG8_SCHED
}
}
#define GAS __attribute__((address_space(1)))
#define LAS __attribute__((address_space(3)))
typedef unsigned short bf16;
typedef unsigned v4u __attribute__((ext_vector_type(4)));
typedef float f32x4 __attribute__((ext_vector_type(4)));
typedef short bf16x8 __attribute__((ext_vector_type(8)));
typedef GAS unsigned gu32;
typedef GAS unsigned long long gu64;
#define RLX_AGENT __ATOMIC_RELAXED, __HIP_MEMORY_SCOPE_AGENT
#define LDS_WAIT() asm volatile("s_waitcnt lgkmcnt(0)" ::: "memory")
#define VM_WAIT() asm volatile("s_waitcnt vmcnt(0)" ::: "memory")
__device__ __forceinline__ unsigned long long rt() { return __builtin_amdgcn_s_memrealtime(); }
__device__ __forceinline__ unsigned f2bf(float f) { unsigned u = __builtin_bit_cast(unsigned, f); return (u + 0x7fffu + ((u >> 16) & 1u)) >> 16; }
__device__ __forceinline__ unsigned pk2(float lo, float hi) { return f2bf(lo) | (f2bf(hi) << 16); }

#define XB_TMO      128
#define XB_XCNT(j)  (256  + 64 * (j))
#define XB_XSUB(j)  (1280 + 64 * (j))
#define XB_XGEN(j)  (2304 + 64 * (j))
#define XB_TOP      3328
#define XB_TOPGEN   3392
#define XCD_BAR_WORDS 3456
#define XB_SPIN_CAP (1u << 18)

__device__ __forceinline__ unsigned xb_ld(unsigned* p)              { return __hip_atomic_load(p, __ATOMIC_RELAXED, __HIP_MEMORY_SCOPE_AGENT); }
__device__ __forceinline__ unsigned xb_add(unsigned* p, unsigned v) { return __hip_atomic_fetch_add(p, v, __ATOMIC_RELAXED, __HIP_MEMORY_SCOPE_AGENT); }
__device__ __forceinline__ unsigned xb_xcc_id() { return (unsigned)__builtin_amdgcn_s_getreg((3 << 11) | 20) & 0xFu; }
#define XB_SPIN(cond, bar) do { unsigned _sp = 0; while (cond) { __builtin_amdgcn_s_sleep(1); \
    if ((++_sp & 255u) == 0u) { if (xb_ld(&(bar)[XB_TMO])) break; if (_sp > XB_SPIN_CAP) { atomicAdd(&(bar)[XB_TMO], 1u); break; } } } } while (0)

struct XcdBarrier {
    unsigned* bar; unsigned x;
    volatile LAS unsigned* st;
};

__device__ __forceinline__ XcdBarrier xcd_barrier_post(unsigned* bar, volatile LAS unsigned* st) {
    XcdBarrier b; b.bar = bar; b.x = xb_xcc_id(); b.st = st;
    if (threadIdx.x == 0) (void)xb_add(&bar[XB_XCNT(b.x)], 1u);
    return b;
}
__device__ __forceinline__ void xcd_barrier_complete(unsigned* bar, unsigned x, unsigned& nloc, unsigned& nx) {
    const unsigned G = gridDim.x * gridDim.y * gridDim.z;
    unsigned sum, cnt, mine, sp = 0u;
    for (;;) {
        sum = 0u; cnt = 0u; mine = 0u;
#pragma unroll
        for (unsigned j = 0; j < 16; ++j) { const unsigned c = xb_ld(&bar[XB_XCNT(j)]); sum += c; cnt += (c > 0u) ? 1u : 0u; mine = (j == x) ? c : mine; }
        if (sum == G) break;
        __builtin_amdgcn_s_sleep(1);
        if ((++sp & 255u) == 0u) { if (xb_ld(&bar[XB_TMO])) break; if (sp > XB_SPIN_CAP) { atomicAdd(&bar[XB_TMO], 1u); break; } }
    }
    nloc = mine > 0u ? mine : 1u; nx = cnt > 0u ? cnt : 1u;
}

__device__ __forceinline__ void xcd_barrier(const XcdBarrier& b) {
    asm volatile("s_waitcnt vmcnt(0)" ::: "memory");
    __syncthreads();
    if (threadIdx.x == 0) {
        unsigned* bar = b.bar;
        __builtin_amdgcn_s_waitcnt(0);
        unsigned nloc = b.st[0], nx = b.st[1];
        if (nloc == 0u) { xcd_barrier_complete(bar, b.x, nloc, nx); b.st[0] = nloc; b.st[1] = nx; }
        const unsigned old = xb_add(&bar[XB_XSUB(b.x)], 1u);
        const unsigned gen = old / nloc;
        if (old + 1u == (gen + 1u) * nloc) {
            __builtin_amdgcn_fence(__ATOMIC_RELEASE, "agent");
            asm volatile("s_waitcnt vmcnt(0)" ::: "memory");
            const unsigned og = xb_add(&bar[XB_TOP], 1u);
            const unsigned tg = og / nx;
            if (og + 1u == (tg + 1u) * nx) xb_add(&bar[XB_TOPGEN], 1u);
            else XB_SPIN(xb_ld(&bar[XB_TOPGEN]) == tg, bar);
            __builtin_amdgcn_fence(__ATOMIC_ACQUIRE, "agent");
            xb_add(&bar[XB_XGEN(b.x)], 1u);
            asm volatile("s_waitcnt vmcnt(0)" ::: "memory");
        } else {
            XB_SPIN(xb_ld(&bar[XB_XGEN(b.x)]) == gen, bar);
            __builtin_amdgcn_fence(__ATOMIC_ACQUIRE, "agent");
            asm volatile("s_waitcnt vmcnt(0)" ::: "memory");
        }
    }
    __syncthreads();
}

constexpr int NWAVES = 8, NTHR = 512;
constexpr int BATCH = 8, SEQ = 4096, DM = 1024, MTOK = BATCH * SEQ;
constexpr int HGW = 512, ABN = 3584, DFF = 2816, UPN = 5632, NSAN = 2816;
constexpr float EPSN = 1e-6f;
constexpr float LOG2E = 1.4426950408889634f;
constexpr float QSCALE = 0.125f * LOG2E;

constexpr size_t MiB = (size_t)1 << 20;
constexpr size_t WS_CTL = 0, CTL_ZERO_BYTES = 1 * MiB;
constexpr size_t WS_MOD = 1 * MiB;
constexpr size_t WS_BV_ABIN = WS_MOD + 393216;
constexpr size_t WS_BV_UP0 = WS_BV_ABIN + 114688;
constexpr size_t WS_BV_NSA = WS_BV_UP0 + 180224;
constexpr size_t WS_BV_UP1 = WS_BV_NSA + 90112;
constexpr size_t WS_LB = WS_BV_UP1 + 180224;
constexpr size_t WS_BUCKET = WS_LB + 2048;
constexpr size_t WS_CMPB = WS_BUCKET + 16384;
static_assert(WS_CMPB + 2048 <= 2 * MiB, "tables");
constexpr size_t WS_SSQ = 3 * MiB;
constexpr size_t WS_DB = 5 * MiB;
constexpr size_t WS_GATES = 6 * MiB;
constexpr size_t WS_W_ABIN = 12 * MiB, WS_W_ABOUT = 19 * MiB, WS_W_NSAIN = 21 * MiB, WS_W_NSAOUT = 27 * MiB;
constexpr size_t WS_W_UP = 29 * MiB, WS_W_DOWN = 51 * MiB, WS_W_CMP1 = 62 * MiB;
constexpr size_t WS_XS = 64 * MiB;
constexpr size_t WS_AO = 128 * MiB;
constexpr size_t WS_QH = 192 * MiB, WS_IV = 224 * MiB, WS_GS = 256 * MiB, WS_GB = 288 * MiB, WS_GC = 320 * MiB, WS_SV = 352 * MiB;
constexpr size_t WS_LF = 384 * MiB;
constexpr size_t WS_UB = 448 * MiB;
constexpr size_t WS_G = 128 * MiB, WS_UP = 304 * MiB;
constexpr size_t WS_QN = 192 * MiB;
constexpr size_t WS_KV6 = 256 * MiB;
constexpr size_t WS_HID = 352 * MiB;
constexpr size_t WS_KCMP = 360 * MiB, WS_VCMP = 361 * MiB;
constexpr size_t WS_END = 512 * MiB;
constexpr size_t KVPANEL = (size_t)SEQ * 64;

constexpr int RING_BYTES = 131072;
constexpr int LDS_BYTES = 147456;

__device__ __forceinline__ unsigned pkbf(float lo, float hi) {
    typedef float f2_t __attribute__((ext_vector_type(2))); typedef __bf16 b2_t __attribute__((ext_vector_type(2)));
    f2_t v = {lo, hi}; b2_t b = __builtin_convertvector(v, b2_t); return __builtin_bit_cast(unsigned, b);
}
__device__ __forceinline__ unsigned short tobf(float f) { return (unsigned short)(pkbf(f, 0.f) & 0xffffu); }
__device__ __forceinline__ float bflo(unsigned u) { return __uint_as_float(u << 16); }
__device__ __forceinline__ float bfhi(unsigned u) { return __uint_as_float(u & 0xffff0000u); }
__device__ __forceinline__ float bf2f(unsigned short u) { return __uint_as_float((unsigned)u << 16); }
__device__ __forceinline__ float sigmoid_f(float v) { return 1.f / (1.f + __expf(-v)); }
__device__ __forceinline__ float silu_f(float v) { return v / (1.f + __expf(-v)); }
__device__ __forceinline__ int crow(int reg, int h) { return (reg & 3) + 8 * (reg >> 2) + 4 * h; }
typedef float f32x16 __attribute__((ext_vector_type(16)));
typedef short s16x4 __attribute__((ext_vector_type(4)));
typedef unsigned u32x2 __attribute__((ext_vector_type(2)));
#define MFMA32(a, b, c) __builtin_amdgcn_mfma_f32_32x32x16_bf16((a), (b), (c), 0, 0, 0)
__device__ __forceinline__ float wave_sum(float v) {
#pragma unroll
    for (int o = 1; o < 64; o <<= 1) v += __shfl_xor(v, o);
    return v;
}

struct Frame {
    LAS unsigned char* lds;
    int tid, lane, wave, vcu, G;
    const float* const* in;
    float* out; unsigned char* ws;
};
#define WSP(T, off) ((T*)(F.ws + (off)))

__device__ __forceinline__ float row_rstd(const float* ssq, int row) {
    const f32x4* p = (const f32x4*)(ssq + (size_t)row * 16);
    const f32x4 a = p[0], b = p[1], c = p[2], d = p[3];
    const float s = ((a.x + a.y) + (a.z + a.w)) + ((b.x + b.y) + (b.z + b.w)) + ((c.x + c.y) + (c.z + c.w)) + ((d.x + d.y) + (d.z + d.w));
    return rsqrtf(s * (1.0f / DM) + EPSN);
}

#define EPI_LOOP_ROWS _Pragma("unroll") for (int ai = 0; ai < 2; ++ai) _Pragma("unroll") for (int m = 0; m < 4; ++m)
#define EPI_LOOP_COLS _Pragma("unroll") for (int bj = 0; bj < 2; ++bj) _Pragma("unroll") for (int n = 0; n < 2; ++n)

struct EpiAbIn {
    static constexpr bool PERM = false, AFTER_DRAIN = false;
    const float* ssq; const float* bv; const float* lb; bf16 *QH, *IV, *GS, *GB, *GC, *SV; float* LF;
    template <int SEG> __device__ __forceinline__ void emit(const f32x4 (&acc)[2][2][4][2], const pg8::Unit& u, int wr, int wc, int fr, int fq) const {
        const int cs0 = (u.pn & 1) * 256;
        EPI_LOOP_ROWS {
            const int row = u.pm * 256 + ai * 128 + wr * 64 + m * 16 + fr; const int b = row >> 12; const float rs = row_rstd(ssq, row);
            EPI_LOOP_COLS {
                const int cl = bj * 128 + wc * 32 + n * 16 + fq * 4, cs = cs0 + cl, cn = u.pn * 256 + cl;
                f32x4 v = acc[ai][bj][m][n] * rs + *(const f32x4*)(bv + b * ABN + cn);
                if (SEG == 1) {
                    const f32x4 l4 = *(const f32x4*)(lb + cs); f32x4 o;
#pragma unroll
                    for (int e = 0; e < 4; ++e) { const float fg = l4[e] + (1.f - l4[e]) * sigmoid_f(v[e]); o[e] = __logf(fg); }
                    *(f32x4*)(LF + (size_t)row * HGW + cs) = o;
                } else {
                    if (SEG == 3) {
#pragma unroll
                        for (int e = 0; e < 4; ++e) v[e] = silu_f(v[e]);
                    }
                    bf16* dst = SEG == 0 ? QH : SEG == 2 ? IV : SEG == 3 ? GS : SEG == 4 ? GB : SEG == 5 ? GC : SV;
                    u32x2 w; w.x = pkbf(v[0], v[1]); w.y = pkbf(v[2], v[3]);
                    *(u32x2*)(dst + (size_t)row * HGW + cs) = w;
                }
            }
        }
    }
    __device__ __forceinline__ void operator()(const f32x4 (&acc)[2][2][4][2], const pg8::Unit& u, int wr, int wc, int fr, int fq) const {
        switch (u.pn >> 1) {
            case 0: emit<0>(acc, u, wr, wc, fr, fq); break; case 1: emit<1>(acc, u, wr, wc, fr, fq); break; case 2: emit<2>(acc, u, wr, wc, fr, fq); break;
            case 3: emit<3>(acc, u, wr, wc, fr, fq); break; case 4: emit<4>(acc, u, wr, wc, fr, fq); break; case 5: emit<5>(acc, u, wr, wc, fr, fq); break;
            default: emit<6>(acc, u, wr, wc, fr, fq); break;
        }
    }
};

struct EpiRes {
    static constexpr bool PERM = false, AFTER_DRAIN = false;
    const float* xin; float* xout; bf16* xs; const float* gate; const float* ng; const float* nsc; float* ssq; int has_next;
    __device__ __forceinline__ void operator()(const f32x4 (&acc)[2][2][4][2], const pg8::Unit& u, int wr, int wc, int fr, int fq) const {
        EPI_LOOP_ROWS {
            const int row = u.pm * 256 + ai * 128 + wr * 64 + m * 16 + fr; const int b = row >> 12; float ss = 0.f;
            EPI_LOOP_COLS {
                const int cn = u.pn * 256 + bj * 128 + wc * 32 + n * 16 + fq * 4; const size_t off = (size_t)row * DM + cn;
                const f32x4 g4 = *(const f32x4*)(gate + b * 6144 + cn);
                const f32x4 xn = *(const f32x4*)(xin + off) + g4 * acc[ai][bj][m][n];
                *(f32x4*)(xout + off) = xn;
                ss += (xn[0] * xn[0] + xn[1] * xn[1]) + (xn[2] * xn[2] + xn[3] * xn[3]);
                if (has_next) {
                    const f32x4 n4 = *(const f32x4*)(ng + cn), s4 = *(const f32x4*)(nsc + b * 6144 + cn);
                    const f32x4 y = xn * (n4 * (1.f + s4));
                    u32x2 w; w.x = pkbf(y[0], y[1]); w.y = pkbf(y[2], y[3]);
                    *(u32x2*)(xs + off) = w;
                }
            }
            ss += __shfl_xor(ss, 16); ss += __shfl_xor(ss, 32);
            if (fq == 0) ssq[(size_t)row * 16 + u.pn * 4 + wc] = ss;
        }
    }
};

struct EpiUp {
    static constexpr bool PERM = false, AFTER_DRAIN = false;
    const float* ssq; const float* bv; bf16 *G, *UP;
    __device__ __forceinline__ void operator()(const f32x4 (&acc)[2][2][4][2], const pg8::Unit& u, int wr, int wc, int fr, int fq) const {
        bf16* dst = u.pn < 11 ? G : UP; const int c0 = (u.pn < 11 ? u.pn : u.pn - 11) * 256;
        EPI_LOOP_ROWS {
            const int row = u.pm * 256 + ai * 128 + wr * 64 + m * 16 + fr; const int b = row >> 12; const float rs = row_rstd(ssq, row);
            EPI_LOOP_COLS {
                const int cl = bj * 128 + wc * 32 + n * 16 + fq * 4;
                const f32x4 v = acc[ai][bj][m][n] * rs + *(const f32x4*)(bv + b * UPN + u.pn * 256 + cl);
                u32x2 w; w.x = pkbf(v[0], v[1]); w.y = pkbf(v[2], v[3]);
                *(u32x2*)(dst + (size_t)row * DFF + c0 + cl) = w;
            }
        }
    }
};

struct EpiNsaIn {
    static constexpr bool PERM = false, AFTER_DRAIN = false;
    const float* ssq; const float* bv; bf16* QN; bf16* KV6; float* GATES;
    __device__ __forceinline__ void operator()(const f32x4 (&acc)[2][2][4][2], const pg8::Unit& u, int wr, int wc, int fr, int fq) const {
        EPI_LOOP_ROWS {
            const int row = u.pm * 256 + ai * 128 + wr * 64 + m * 16 + fr; const int b = row >> 12, t = row & (SEQ - 1); const float rs = row_rstd(ssq, row);
            EPI_LOOP_COLS {
                const int cl = bj * 128 + wc * 32 + n * 16 + fq * 4;
                f32x4 v = acc[ai][bj][m][n] * rs + *(const f32x4*)(bv + b * NSAN + u.pn * 256 + cl);
                if (u.pn < 4) {
                    v = v * QSCALE; u32x2 w; w.x = pkbf(v[0], v[1]); w.y = pkbf(v[2], v[3]);
                    *(u32x2*)(QN + (size_t)row * DM + u.pn * 256 + cl) = w;
                } else if (u.pn < 10) {
                    const int idx = u.pn - 4, g = cl >> 6, d = cl & 63;
                    u32x2 w; w.x = pkbf(v[0], v[1]); w.y = pkbf(v[2], v[3]);
                    *(u32x2*)(KV6 + ((size_t)((idx * BATCH + b) * 4 + g)) * KVPANEL + (size_t)t * 64 + d) = w;
                } else if (cl < 48) {
                    f32x4 o;
#pragma unroll
                    for (int e = 0; e < 4; ++e) o[e] = sigmoid_f(v[e]);
                    *(f32x4*)(GATES + (size_t)row * 48 + cl) = o;
                }
            }
        }
    }
};

struct EpiCmp1 {
    static constexpr bool PERM = false, AFTER_DRAIN = false;
    const float* cb; bf16* HID;
    __device__ __forceinline__ void operator()(const f32x4 (&acc)[2][2][4][2], const pg8::Unit& u, int wr, int wc, int fr, int fq) const {
        EPI_LOOP_ROWS {
            const int row = u.pm * 256 + ai * 128 + wr * 64 + m * 16 + fr;
            EPI_LOOP_COLS {
                const int cl = bj * 128 + wc * 32 + n * 16 + fq * 4;
                const f32x4 v = acc[ai][bj][m][n] + *(const f32x4*)(cb + cl);
                u32x2 w; w.x = pkbf(silu_f(v[0]), silu_f(v[1])); w.y = pkbf(silu_f(v[2]), silu_f(v[3]));
                *(u32x2*)(HID + (size_t)row * 256 + cl) = w;
            }
        }
    }
};
struct OffsetOrder {
    int nM, nN, nwg, G, c;
    __device__ void init(int M_, int N_, int G_, int c_, int off) { nM = M_ / 256; nN = N_ / 256; nwg = nM * nN; G = G_; c = (c_ - off + 4 * G_) % G_; }
    __device__ bool next(int i, pg8::Unit& u) const { const long L = (long)i * G + c; if (L >= nwg) return false; u.pm = (int)L / nN; u.pn = (int)L % nN; return true; }
    __device__ __forceinline__ void a_ready(const pg8::Unit&) const {}
    __device__ __forceinline__ void done(const pg8::Unit&) const {}
};

__device__ __forceinline__ void transpose_item(const float* W, int K, int N, bf16* WT, int k0, int dst_row0, int src_col0, int nvalid, LAS float* scr, int lane) {
    const int j = lane & 31; const bool ok = j < nvalid;
#pragma unroll 8
    for (int i = 0; i < 32; ++i) { const int kk = 2 * i + (lane >> 5); scr[kk * 33 + j] = ok ? W[(size_t)(k0 + kk) * N + src_col0 + j] : 0.f; }
    LDS_WAIT(); asm volatile("" ::: "memory");
    const int c = lane & 7;
#pragma unroll
    for (int j4 = 0; j4 < 4; ++j4) { const int n = (lane >> 3) + 8 * j4; const LAS float* s = scr + (8 * c) * 33 + n;
        v4u o; o.x = pkbf(s[0 * 33], s[1 * 33]); o.y = pkbf(s[2 * 33], s[3 * 33]); o.z = pkbf(s[4 * 33], s[5 * 33]); o.w = pkbf(s[6 * 33], s[7 * 33]);
        *(v4u*)(WT + (size_t)(dst_row0 + n) * K + k0 + 8 * c) = o; }
    LDS_WAIT(); asm volatile("" ::: "memory");
}
__device__ __forceinline__ void nsa_colmap(int nb, int& src0, int& nv) {
    if (nb < 32) { src0 = 32 * nb; nv = 32; }
    else if (nb < 80) { src0 = 32 * nb + 48; nv = 32; }
    else if (nb == 80) { src0 = 1024; nv = 32; }
    else if (nb == 81) { src0 = 1056; nv = 16; }
    else { src0 = 0; nv = 0; }
}
template <class OutF> __device__ __forceinline__ void gemv8_item(const float* W, int ldw, int K, int src_col0, int nvalid, const LAS float* coef, LAS float* red, int tid, OutF out) {
    const int cl = tid & 31, kg = tid >> 5;
    float acc[8];
#pragma unroll
    for (int b = 0; b < 8; ++b) acc[b] = 0.f;
    const bool valid = cl < nvalid;
    const float* wp = W + (size_t)kg * ldw + src_col0 + cl;
#pragma unroll 4
    for (int kk = 0; kk < K / 16; ++kk) { const float w = valid ? wp[(size_t)kk * 16 * ldw] : 0.f; const int k = kg + 16 * kk;
#pragma unroll
        for (int b = 0; b < 8; ++b) acc[b] += coef[b * K + k] * w; }
#pragma unroll
    for (int b = 0; b < 8; ++b) red[(kg * 8 + b) * 32 + cl] = acc[b];
    __syncthreads();
    if (tid < 256) { const int b = tid >> 5; float s = 0.f;
#pragma unroll
        for (int k2 = 0; k2 < 16; ++k2) s += red[(k2 * 8 + b) * 32 + cl];
        out(b, cl, s); }
    __syncthreads();
}
constexpr int P0_TSCR = 0, P0_COEF = 69632, P0_RED = 102400;

__device__ __forceinline__ void p0a(Frame& F) {
    LAS float* coef = (LAS float*)(F.lds + P0_COEF); LAS float* red = (LAS float*)(F.lds + P0_RED);
    const float* c = F.in[1];
    for (int i = F.tid; i < 8 * 1024; i += NTHR) coef[i] = silu_f(c[i]);
    __syncthreads();
    float* MOD = WSP(float, WS_MOD);
    for (int it = F.vcu; it < 386; it += F.G) {
        if (it < 384) {
            const int l = it / 192, col0 = 32 * (it % 192); const float* mb = F.in[3] + l * 6144;
            gemv8_item(F.in[2] + (size_t)l * 1024 * 6144, 6144, 1024, col0, 32, coef, red, F.tid,
                       [&](int b, int cl, float s) { MOD[(l * 8 + b) * 6144 + col0 + cl] = s + mb[col0 + cl]; });
        } else {
            const int which = it - 384; const float* pos = F.in[13 + which]; const float* w1 = F.in[which ? 17 : 15];
            const int n = F.tid & 255, hf = F.tid >> 8; float s = 0.f;
#pragma unroll 4
            for (int k = hf * 1024; k < hf * 1024 + 1024; ++k) s += pos[k] * w1[(size_t)k * 256 + n];
            red[hf * 256 + n] = s; __syncthreads();
            if (F.tid < 256) WSP(float, WS_CMPB)[which * 256 + n] = red[n] + red[256 + n];
            __syncthreads();
        }
    }
    LAS float* scr = (LAS float*)(F.lds + P0_TSCR + F.wave * 8704);
    const int gw = F.vcu * NWAVES + F.wave, NGW = F.G * NWAVES;
    constexpr int I_ABIN = 16 * 112, I_ABOUT = 16 * 32, I_NSAIN = 16 * 88, I_NSAOUT = 16 * 32, I_UP = 16 * 176, I_DOWN = 44 * 32, I_CMP = 32 * 8;
    constexpr int NITEMS = I_ABIN + I_ABOUT + I_NSAIN + I_NSAOUT + 2 * I_UP + 2 * I_DOWN + 2 * I_CMP;
    for (int it = gw; it < NITEMS; it += NGW) {
        int r = it;
        if (r < I_ABIN) { transpose_item(F.in[6], 1024, ABN, WSP(bf16, WS_W_ABIN), 64 * (r / 112), 32 * (r % 112), 32 * (r % 112), 32, scr, F.lane); continue; } r -= I_ABIN;
        if (r < I_ABOUT) { transpose_item(F.in[7], 1024, 1024, WSP(bf16, WS_W_ABOUT), 64 * (r / 32), 32 * (r % 32), 32 * (r % 32), 32, scr, F.lane); continue; } r -= I_ABOUT;
        if (r < I_NSAIN) { int s0, nv; nsa_colmap(r % 88, s0, nv); transpose_item(F.in[11], 1024, 2608, WSP(bf16, WS_W_NSAIN), 64 * (r / 88), 32 * (r % 88), s0, nv, scr, F.lane); continue; } r -= I_NSAIN;
        if (r < I_NSAOUT) { transpose_item(F.in[12], 1024, 1024, WSP(bf16, WS_W_NSAOUT), 64 * (r / 32), 32 * (r % 32), 32 * (r % 32), 32, scr, F.lane); continue; } r -= I_NSAOUT;
        if (r < 2 * I_UP) { const int l = r / I_UP; r %= I_UP; transpose_item(F.in[20] + (size_t)l * 1024 * UPN, 1024, UPN, WSP(bf16, WS_W_UP) + (size_t)l * UPN * 1024, 64 * (r / 176), 32 * (r % 176), 32 * (r % 176), 32, scr, F.lane); continue; } r -= 2 * I_UP;
        if (r < 2 * I_DOWN) { const int l = r / I_DOWN; r %= I_DOWN; transpose_item(F.in[22] + (size_t)l * DFF * 1024, DFF, 1024, WSP(bf16, WS_W_DOWN) + (size_t)l * 1024 * DFF, 64 * (r / 32), 32 * (r % 32), 32 * (r % 32), 32, scr, F.lane); continue; } r -= 2 * I_DOWN;
        { const int which = r / I_CMP; r %= I_CMP; transpose_item(F.in[which ? 17 : 15], 2048, 256, WSP(bf16, WS_W_CMP1) + (size_t)which * 256 * 2048, 64 * (r / 8), 32 * (r % 8), 32 * (r % 8), 32, scr, F.lane); }
    }
    const int gt = F.vcu * NTHR + F.tid;
    if (gt < 4096) { int bk = gt; if (gt >= 16) { const float x = log2f((float)gt * 0.0625f) * 2.6666667f + 1e-5f; bk = 16 + (int)floorf(x); if (bk > 31) bk = 31; } WSP(int, WS_BUCKET)[gt] = bk; }
    if (gt < 512) { const float a = F.in[8][gt], b2 = F.in[8][512 + gt]; const float mx = fmaxf(a, b2); const float ea = __expf(a - mx), eb = __expf(b2 - mx); WSP(float, WS_LB)[gt] = ea / (ea + eb); }
}

__device__ __forceinline__ void p0b(Frame& F) {
    LAS float* coef = (LAS float*)(F.lds + P0_COEF); LAS float* red = (LAS float*)(F.lds + P0_RED);
    const float* MOD = WSP(float, WS_MOD);
    int curm = -1;
    for (int it = F.vcu; it < 552; it += F.G) {
        int mid, r = it;
        if (r < 112) mid = 0; else if ((r -= 112) < 176) mid = 1; else if ((r -= 176) < 88) mid = 2; else { r -= 88; mid = 3; }
        if (mid != curm) {
            __syncthreads();
            const int l = mid >> 1, off = (mid & 1) ? 3072 : 0;
            for (int i = F.tid; i < 8192; i += NTHR) coef[i] = MOD[(l * 8 + (i >> 10)) * 6144 + off + (i & 1023)];
            __syncthreads(); curm = mid;
        }
        if (mid == 0) { float* o = WSP(float, WS_BV_ABIN); gemv8_item(F.in[6], ABN, 1024, 32 * r, 32, coef, red, F.tid, [&](int b, int cl, float s) { o[b * ABN + 32 * r + cl] = s; }); }
        else if (mid == 1) { float* o = WSP(float, WS_BV_UP0); gemv8_item(F.in[20], UPN, 1024, 32 * r, 32, coef, red, F.tid, [&](int b, int cl, float s) { o[b * UPN + 32 * r + cl] = s; }); }
        else if (mid == 2) { float* o = WSP(float, WS_BV_NSA); int s0, nv; nsa_colmap(r, s0, nv); gemv8_item(F.in[11], 2608, 1024, s0, nv, coef, red, F.tid, [&](int b, int cl, float s) { o[b * NSAN + 32 * r + cl] = s; }); }
        else { float* o = WSP(float, WS_BV_UP1); gemv8_item(F.in[20] + (size_t)1024 * UPN, UPN, 1024, 32 * r, 32, coef, red, F.tid, [&](int b, int cl, float s) { o[b * UPN + 32 * r + cl] = s; }); }
    }
    const int gw = F.vcu * NWAVES + F.wave, NGW = F.G * NWAVES;
    const float* x = F.in[0]; const float* ng = F.in[4]; bf16* XS = WSP(bf16, WS_XS); float* SSQ = WSP(float, WS_SSQ);
    for (int m = gw; m < MTOK; m += NGW) {
        const int b = m >> 12; float ss = 0.f;
#pragma unroll
        for (int j = 0; j < 4; ++j) { const int col = 4 * F.lane + 256 * j;
            const f32x4 v = *(const f32x4*)(x + (size_t)m * DM + col); const f32x4 g4 = *(const f32x4*)(ng + col), s4 = *(const f32x4*)(MOD + b * 6144 + 1024 + col);
            ss += (v[0] * v[0] + v[1] * v[1]) + (v[2] * v[2] + v[3] * v[3]);
            const f32x4 y = v * (g4 * (1.f + s4)); u32x2 w; w.x = pkbf(y[0], y[1]); w.y = pkbf(y[2], y[3]);
            *(u32x2*)(XS + (size_t)m * DM + col) = w; }
        ss = wave_sum(ss);
        if (F.lane < 16) SSQ[(size_t)m * 16 + F.lane] = F.lane == 0 ? ss : 0.f;
    }
}

__device__ __forceinline__ void hgrn_s1_unit(Frame& F, int u) {
    const int bh = u >> 6, c = u & 63, b = bh >> 2, h = bh & 3; const size_t row0 = (size_t)b * SEQ + 64 * c;
    LAS float* SEGT = (LAS float*)(F.lds); LAS bf16* KT = (LAS bf16*)(F.lds + 2048); LAS bf16* VT = (LAS bf16*)(F.lds + 2048 + 18432);
    const int tid = F.tid, k = tid & 127, seg = tid >> 7;
    float kk[16], bl[16]; float acc = 0.f;
    { const float* lfp = WSP(float, WS_LF) + (row0 + 16 * seg) * HGW + h * 128 + k;
#pragma unroll
      for (int i = 0; i < 16; ++i) { const float v = lfp[(size_t)i * HGW]; kk[i] = 1.f - __expf(v); acc += v; bl[i] = acc; } }
    SEGT[seg * 128 + k] = acc;
    { const bf16* ivp = WSP(bf16, WS_IV) + row0 * HGW + h * 128;
#pragma unroll
      for (int rnd = 0; rnd < 2; ++rnd) { const int idx = tid + NTHR * rnd, s = idx >> 4, ch = idx & 15; const v4u v = *(const v4u*)(ivp + (size_t)s * HGW + 8 * ch);
#pragma unroll
          for (int e = 0; e < 8; ++e) VT[(8 * ch + e) * 72 + s] = (bf16)((e & 1) ? (v[e >> 1] >> 16) : (v[e >> 1] & 0xffffu)); } }
    __syncthreads();
    float pre = 0.f, tot = 0.f;
#pragma unroll
    for (int s2 = 0; s2 < 4; ++s2) { const float x = SEGT[s2 * 128 + k]; tot += x; if (s2 < seg) pre += x; }
    { unsigned pk[8];
#pragma unroll
      for (int i = 0; i < 16; i += 2) pk[i >> 1] = pkbf(kk[i] * __expf(tot - (bl[i] + pre)), kk[i + 1] * __expf(tot - (bl[i + 1] + pre)));
      *(LAS v4u*)(KT + k * 72 + 16 * seg) = (v4u){pk[0], pk[1], pk[2], pk[3]}; *(LAS v4u*)(KT + k * 72 + 16 * seg + 8) = (v4u){pk[4], pk[5], pk[6], pk[7]}; }
    if (seg == 0) WSP(float, WS_DB)[(size_t)u * 128 + k] = __expf(tot);
    __syncthreads();
    const int r = F.lane & 31, hh = F.lane >> 5, ti = F.wave >> 1;
    bf16* up = WSP(bf16, WS_UB) + (size_t)u * 16384;
#pragma unroll
    for (int tt = 0; tt < 2; ++tt) { const int tj = 2 * (F.wave & 1) + tt; f32x16 a16 = {};
#pragma unroll
        for (int ks = 0; ks < 4; ++ks) { const bf16x8 a = *(const LAS bf16x8*)(KT + (32 * ti + r) * 72 + 16 * ks + 8 * hh), bb = *(const LAS bf16x8*)(VT + (32 * tj + r) * 72 + 16 * ks + 8 * hh); a16 = MFMA32(a, bb, a16); }
#pragma unroll
        for (int reg = 0; reg < 16; ++reg) up[(32 * ti + crow(reg, hh)) * 128 + 32 * tj + r] = tobf(a16[reg]); }
    __syncthreads();
}
__device__ __forceinline__ void hgrn_s2(Frame& F) {
    unsigned* UB = WSP(unsigned, WS_UB); const float* DB = WSP(float, WS_DB);
    for (int idx = F.vcu * NTHR + F.tid; idx < 32 * 8192; idx += F.G * NTHR) {
        const int bh = idx >> 13, e = idx & 8191, k = e >> 6, v2 = e & 63;
        unsigned* p = UB + (size_t)bh * 64 * 8192 + k * 64 + v2; const float* dp = DB + (size_t)bh * 64 * 128 + k;
        float s0 = 0.f, s1 = 0.f;
#pragma unroll 8
        for (int c = 0; c < 64; ++c) { const unsigned uu = p[(size_t)c * 8192]; const float dd = dp[c * 128]; p[(size_t)c * 8192] = pkbf(s0, s1); s0 = dd * s0 + bflo(uu); s1 = dd * s1 + bfhi(uu); }
    }
}
__device__ __forceinline__ void hgrn_s3_unit(Frame& F, int u) {
    const int bh = u >> 6, c = u & 63, b = bh >> 2, h = bh & 3; const size_t row0 = (size_t)b * SEQ + 64 * c;
    LAS float* SEGT = (LAS float*)(F.lds); LAS float* SSQP = (LAS float*)(F.lds + 2048);
    LAS bf16* QP = (LAS bf16*)(F.lds + 4096); LAS bf16* KP = (LAS bf16*)(F.lds + 21504); LAS bf16* AM = (LAS bf16*)(F.lds + 38912);
    LAS bf16* VT = (LAS bf16*)(F.lds + 48128); LAS bf16* ST = (LAS bf16*)(F.lds + 66560);
    const int tid = F.tid, k = tid & 127, seg = tid >> 7;
    float kk[16], bl[16], qv[16]; float acc = 0.f;
    { const float* lfp = WSP(float, WS_LF) + (row0 + 16 * seg) * HGW + h * 128 + k; const bf16* qp = WSP(bf16, WS_QH) + (row0 + 16 * seg) * HGW + h * 128 + k;
#pragma unroll
      for (int i = 0; i < 16; ++i) { const float v = lfp[(size_t)i * HGW]; qv[i] = bf2f(qp[(size_t)i * HGW]); kk[i] = 1.f - __expf(v); acc += v; bl[i] = acc; } }
    SEGT[seg * 128 + k] = acc;
    { const bf16* ivp = WSP(bf16, WS_IV) + row0 * HGW + h * 128;
#pragma unroll
      for (int rnd = 0; rnd < 2; ++rnd) { const int idx = tid + NTHR * rnd, s = idx >> 4, ch = idx & 15; const v4u v = *(const v4u*)(ivp + (size_t)s * HGW + 8 * ch);
#pragma unroll
          for (int e = 0; e < 8; ++e) VT[(8 * ch + e) * 72 + s] = (bf16)((e & 1) ? (v[e >> 1] >> 16) : (v[e >> 1] & 0xffffu)); }
      const bf16* sp = WSP(bf16, WS_UB) + (size_t)u * 16384;
#pragma unroll
      for (int rnd = 0; rnd < 4; ++rnd) { const int idx = tid + NTHR * rnd, k2 = idx >> 4, ch = idx & 15; const v4u v = *(const v4u*)(sp + k2 * 128 + 8 * ch);
#pragma unroll
          for (int e = 0; e < 8; ++e) ST[(8 * ch + e) * 136 + k2] = (bf16)((e & 1) ? (v[e >> 1] >> 16) : (v[e >> 1] & 0xffffu)); } }
    __syncthreads();
    float pre = 0.f;
#pragma unroll
    for (int s2 = 0; s2 < 4; ++s2) { const float x = SEGT[s2 * 128 + k]; if (s2 < seg) pre += x; }
#pragma unroll
    for (int i = 0; i < 16; ++i) { const float bi = bl[i] + pre; QP[(16 * seg + i) * 136 + k] = tobf(qv[i] * __expf(bi)); KP[(16 * seg + i) * 136 + k] = tobf(kk[i] * __expf(-bi)); }
    __syncthreads();
    const int r = F.lane & 31, hh = F.lane >> 5, w = F.wave;
    if (w < 3) { const int ti = w ? 1 : 0, tj = w == 2 ? 1 : 0; f32x16 a16 = {};
#pragma unroll
        for (int ks = 0; ks < 8; ++ks) { const bf16x8 a = *(const LAS bf16x8*)(QP + (32 * ti + r) * 136 + 16 * ks + 8 * hh), bb = *(const LAS bf16x8*)(KP + (32 * tj + r) * 136 + 16 * ks + 8 * hh); a16 = MFMA32(a, bb, a16); }
#pragma unroll
        for (int reg = 0; reg < 16; ++reg) { const int t = 32 * ti + crow(reg, hh), s = 32 * tj + r; AM[t * 72 + s] = tobf(s <= t ? a16[reg] : 0.f); }
    } else if (w == 3) {
#pragma unroll
        for (int reg = 0; reg < 16; ++reg) AM[crow(reg, hh) * 72 + 32 + r] = 0;
    }
    __syncthreads();
    const int ti = w >> 2, tj = w & 3; f32x16 o16 = {};
#pragma unroll
    for (int ks = 0; ks < 4; ++ks) { const bf16x8 a = *(const LAS bf16x8*)(AM + (32 * ti + r) * 72 + 16 * ks + 8 * hh), bb = *(const LAS bf16x8*)(VT + (32 * tj + r) * 72 + 16 * ks + 8 * hh); o16 = MFMA32(a, bb, o16); }
#pragma unroll
    for (int ks = 0; ks < 8; ++ks) { const bf16x8 a = *(const LAS bf16x8*)(QP + (32 * ti + r) * 136 + 16 * ks + 8 * hh), bb = *(const LAS bf16x8*)(ST + (32 * tj + r) * 136 + 16 * ks + 8 * hh); o16 = MFMA32(a, bb, o16); }
#pragma unroll
    for (int reg = 0; reg < 16; ++reg) { float x = o16[reg] * o16[reg]; x += __shfl_xor(x, 1); x += __shfl_xor(x, 2); x += __shfl_xor(x, 4); x += __shfl_xor(x, 8); x += __shfl_xor(x, 16);
        if (r == 0) SSQP[(32 * ti + crow(reg, hh)) * 4 + tj] = x; }
    __syncthreads();
    { const int v = 32 * tj + r; const float og = F.in[9][v]; const bf16* gsp = WSP(bf16, WS_GS) + row0 * HGW + h * 128 + v; bf16* aop = WSP(bf16, WS_AO) + row0 * DM + h * 128 + v;
#pragma unroll
      for (int reg = 0; reg < 16; ++reg) { const int t = 32 * ti + crow(reg, hh); const float rs = rsqrtf(((SSQP[t * 4] + SSQP[t * 4 + 1]) + (SSQP[t * 4 + 2] + SSQP[t * 4 + 3])) * (1.f / 128.f) + EPSN);
          aop[(size_t)t * DM] = tobf(o16[reg] * rs * og * bf2f(gsp[(size_t)t * HGW])); } }
    __syncthreads();
}
__device__ __forceinline__ void sconv_pass(Frame& F) {
    const bf16 *GBp = WSP(bf16, WS_GB), *GCp = WSP(bf16, WS_GC), *SVp = WSP(bf16, WS_SV); bf16* AO = WSP(bf16, WS_AO); const float* cw = F.in[10];
    for (int idx = F.vcu * NTHR + F.tid; idx < MTOK * 64; idx += F.G * NTHR) {
        const int row = idx >> 6, col = (idx & 63) * 8, t = row & (SEQ - 1); const size_t o0 = (size_t)row * HGW + col;
        const v4u gb = *(const v4u*)(GBp + o0); v4u c0 = *(const v4u*)(GCp + o0), s0 = *(const v4u*)(SVp + o0), c1 = {}, s1 = {}, c2 = {}, s2 = {};
        if (t >= 1) { c1 = *(const v4u*)(GCp + o0 - HGW); s1 = *(const v4u*)(SVp + o0 - HGW); }
        if (t >= 2) { c2 = *(const v4u*)(GCp + o0 - 2 * HGW); s2 = *(const v4u*)(SVp + o0 - 2 * HGW); }
        float o[8];
#pragma unroll
        for (int e = 0; e < 8; ++e) { const int q = e >> 1; const bool hi = e & 1;
            const float u0 = (hi ? bfhi(c0[q]) : bflo(c0[q])) * (hi ? bfhi(s0[q]) : bflo(s0[q])), u1 = (hi ? bfhi(c1[q]) : bflo(c1[q])) * (hi ? bfhi(s1[q]) : bflo(s1[q])), u2 = (hi ? bfhi(c2[q]) : bflo(c2[q])) * (hi ? bfhi(s2[q]) : bflo(s2[q]));
            o[e] = (hi ? bfhi(gb[q]) : bflo(gb[q])) * (cw[col + e] * u2 + cw[512 + col + e] * u1 + cw[1024 + col + e] * u0); }
        *(v4u*)(AO + (size_t)row * DM + 512 + col) = (v4u){pkbf(o[0], o[1]), pkbf(o[2], o[3]), pkbf(o[4], o[5]), pkbf(o[6], o[7])};
    }
}
__device__ __forceinline__ void convact_pass(Frame& F, const float* cw) {
    const bf16* Gp = WSP(bf16, WS_G); bf16* UPp = WSP(bf16, WS_UP);
    for (size_t idx = (size_t)F.vcu * NTHR + F.tid; idx < (size_t)MTOK * 352; idx += (size_t)F.G * NTHR) {
        const int row = (int)(idx / 352), col = (int)(idx % 352) * 8, t = row & (SEQ - 1); const size_t o0 = (size_t)row * DFF + col;
        const v4u g0 = *(const v4u*)(Gp + o0), up = *(const v4u*)(UPp + o0); v4u g1 = {}, g2 = {};
        if (t >= 1) g1 = *(const v4u*)(Gp + o0 - DFF);
        if (t >= 2) g2 = *(const v4u*)(Gp + o0 - 2 * DFF);
        float o[8];
#pragma unroll
        for (int e = 0; e < 8; ++e) { const int q = e >> 1; const bool hi = e & 1;
            const float a = cw[col + e] * (hi ? bfhi(g2[q]) : bflo(g2[q])) + cw[DFF + col + e] * (hi ? bfhi(g1[q]) : bflo(g1[q])) + cw[2 * DFF + col + e] * (hi ? bfhi(g0[q]) : bflo(g0[q]));
            o[e] = silu_f(a) * (hi ? bfhi(up[q]) : bflo(up[q])); }
        *(v4u*)(UPp + o0) = (v4u){pkbf(o[0], o[1]), pkbf(o[2], o[3]), pkbf(o[4], o[5]), pkbf(o[6], o[7])};
    }
}
__device__ __forceinline__ void cmp2_pass(Frame& F) {
    for (int idx = F.vcu * NTHR + F.tid; idx < 2 * 8192 * 64; idx += F.G * NTHR) {
        const int which = idx >> 19, r = (idx >> 6) & 8191, d = idx & 63; float s = 0.f;
        if ((r & 255) < 255) { const v4u* hp = (const v4u*)(WSP(bf16, WS_HID) + ((size_t)which * 8192 + r) * 256); const float* w2 = F.in[which ? 18 : 16] + d;
#pragma unroll 4
            for (int n8 = 0; n8 < 32; ++n8) { const v4u hv = hp[n8];
#pragma unroll
                for (int q = 0; q < 4; ++q) { s += bflo(hv[q]) * w2[(8 * n8 + 2 * q) * 64]; s += bfhi(hv[q]) * w2[(8 * n8 + 2 * q + 1) * 64]; } } }
        WSP(bf16, which ? WS_VCMP : WS_KCMP)[(size_t)r * 64 + d] = tobf(s);
    }
}
__device__ __forceinline__ void final_pass(Frame& F) {
    const int gw = F.vcu * NWAVES + F.wave, NGW = F.G * NWAVES; const float* fg = F.in[23];
    for (int m = gw; m < MTOK; m += NGW) { f32x4 v[4]; float ss = 0.f;
#pragma unroll
        for (int j = 0; j < 4; ++j) { v[j] = *(const f32x4*)(F.out + (size_t)m * DM + 4 * F.lane + 256 * j); ss += (v[j][0] * v[j][0] + v[j][1] * v[j][1]) + (v[j][2] * v[j][2] + v[j][3] * v[j][3]); }
        const float rs = rsqrtf(wave_sum(ss) * (1.f / DM) + EPSN);
#pragma unroll
        for (int j = 0; j < 4; ++j) *(f32x4*)(F.out + (size_t)m * DM + 4 * F.lane + 256 * j) = v[j] * rs * *(const f32x4*)(fg + 4 * F.lane + 256 * j); }
}

constexpr int AT_LUT = 0, AT_K = 65536, AT_V = AT_K + 9216, AT_IA = AT_V + 9216, AT_IB = AT_IA + 16384, AT_SEL = AT_IB + 16640, AT_WOR = AT_SEL + 512, AT_WSF = AT_WOR + 64, AT_END = AT_WSF + 8 * 32 * 4;
static_assert(AT_END <= RING_BYTES, "attention LDS");
__device__ __forceinline__ void at_load_k(LAS unsigned char* lds, const bf16* src, int tid) {
    const int row = tid >> 3, ch = tid & 7; *(LAS v4u*)(lds + AT_K + row * 144 + ch * 16) = *(const v4u*)(src + row * 64 + ch * 8);
}
__device__ __forceinline__ void at_load_vt(LAS unsigned char* lds, const bf16* src, int tid) {
    const int row = tid >> 3, ch = tid & 7; const v4u v = *(const v4u*)(src + row * 64 + ch * 8); LAS bf16* vt = (LAS bf16*)(lds + AT_V);
#pragma unroll
    for (int e = 0; e < 8; ++e) vt[(8 * ch + e) * 72 + row] = (bf16)((e & 1) ? (v[e >> 1] >> 16) : (v[e >> 1] & 0xffffu));
}
__device__ __forceinline__ void at_scores(f32x16& p0, f32x16& p1, const LAS unsigned char* lds, const bf16x8 (&qr)[4], int c, int h) {
    p0 = (f32x16){}; p1 = (f32x16){};
    const LAS unsigned char* kb = lds + AT_K + c * 144 + h * 16;
#pragma unroll
    for (int ks = 0; ks < 4; ++ks) { const bf16x8 a0 = *(const LAS bf16x8*)(kb + ks * 32), a1 = *(const LAS bf16x8*)(kb + 32 * 144 + ks * 32); p0 = MFMA32(a0, qr[ks], p0); p1 = MFMA32(a1, qr[ks], p1); }
}
__device__ __forceinline__ bf16x8 pack8(const f32x16& p, int s) {
    v4u w; w.x = pkbf(p[8 * s], p[8 * s + 1]); w.y = pkbf(p[8 * s + 2], p[8 * s + 3]); w.z = pkbf(p[8 * s + 4], p[8 * s + 5]); w.w = pkbf(p[8 * s + 6], p[8 * s + 7]);
    return __builtin_bit_cast(bf16x8, w);
}
__device__ __forceinline__ void at_pv(const f32x16& p0, const f32x16& p1, f32x16 (&o)[2], const LAS unsigned char* lds, int c, int h) {
    const LAS unsigned char* vb = lds + AT_V + c * 144 + h * 8;
#pragma unroll
    for (int sub = 0; sub < 2; ++sub)
#pragma unroll
        for (int s = 0; s < 2; ++s) { const bf16x8 A = pack8(sub ? p1 : p0, s);
#pragma unroll
            for (int db = 0; db < 2; ++db) { const LAS unsigned char* bp = vb + db * 32 * 144 + (32 * sub + 16 * s) * 2;
                const s16x4 lo = *(const LAS s16x4*)(bp), hi = *(const LAS s16x4*)(bp + 16);
                const bf16x8 B = __builtin_shufflevector(lo, hi, 0, 1, 2, 3, 4, 5, 6, 7); o[db] = MFMA32(A, B, o[db]); } }
}
__device__ __forceinline__ void at_softmax(f32x16& s0, f32x16& s1, float& m, float& l, f32x16 (&o)[2], LAS float* wsf, int c, int h, bool rescale_o) {
    float mx = fmaxf(s0[0], s1[0]);
#pragma unroll
    for (int r = 1; r < 16; ++r) mx = fmaxf(mx, fmaxf(s0[r], s1[r]));
    mx = fmaxf(mx, __shfl_xor(mx, 32));
    const float mn = fmaxf(m, mx), alpha = __builtin_amdgcn_exp2f(m - mn); m = mn;
    float sum = 0.f;
#pragma unroll
    for (int r = 0; r < 16; ++r) { s0[r] = __builtin_amdgcn_exp2f(s0[r] - mn); s1[r] = __builtin_amdgcn_exp2f(s1[r] - mn); sum += s0[r] + s1[r]; }
    sum += __shfl_xor(sum, 32); l = l * alpha + sum;
    if (rescale_o) {
        if (h == 0) wsf[c] = alpha;
        asm volatile("s_waitcnt lgkmcnt(0)" ::: "memory");
#pragma unroll
        for (int r = 0; r < 16; ++r) { const float a = wsf[crow(r, h)]; o[0][r] *= a; o[1][r] *= a; }
    }
}
__device__ __forceinline__ void at_accum(f32x16 (&acc)[2], const f32x16 (&o)[2], float fac, LAS float* wsf, int c, int h) {
    asm volatile("s_waitcnt lgkmcnt(0)" ::: "memory");
    if (h == 0) wsf[c] = fac;
    asm volatile("s_waitcnt lgkmcnt(0)" ::: "memory");
#pragma unroll
    for (int r = 0; r < 16; ++r) { const float a = wsf[crow(r, h)]; acc[0][r] += o[0][r] * a; acc[1][r] += o[1][r] * a; }
}

__device__ __forceinline__ void attn_unit(Frame& F, int b, int g, int qb) {
    LAS unsigned char* lds = F.lds;
    const LAS float* LUT = (const LAS float*)(lds + AT_LUT);
    LAS float* IA = (LAS float*)(lds + AT_IA); LAS float* IB = (LAS float*)(lds + AT_IB);
    LAS unsigned* SEL = (LAS unsigned*)(lds + AT_SEL); LAS unsigned* WOR = (LAS unsigned*)(lds + AT_WOR);
    const int tid = F.tid, lane = F.lane, w = F.wave, c = lane & 31, h = lane >> 5, i = c >> 3, q = 8 * w + (c & 7);
    LAS float* wsf = (LAS float*)(lds + AT_WSF) + w * 32;
    const int t0 = 64 * qb, t = t0 + q; const size_t rowbase = (size_t)b * SEQ;
    const bf16* KV6 = WSP(bf16, WS_KV6);
    const bf16* kc = WSP(bf16, WS_KCMP) + (size_t)(b * 4 + g) * 256 * 64; const bf16* vc = WSP(bf16, WS_VCMP) + (size_t)(b * 4 + g) * 256 * 64;
    const bf16* ksp = KV6 + (size_t)((2 * BATCH + b) * 4 + g) * KVPANEL; const bf16* vsp = KV6 + (size_t)((3 * BATCH + b) * 4 + g) * KVPANEL;
    const bf16* kwp = KV6 + (size_t)((4 * BATCH + b) * 4 + g) * KVPANEL; const bf16* vwp = KV6 + (size_t)((5 * BATCH + b) * 4 + g) * KVPANEL;
    bf16x8 qr[4];
    { const bf16* qp = WSP(bf16, WS_QN) + (rowbase + t) * DM + (g * 4 + i) * 64 + 8 * h;
#pragma unroll
      for (int ks = 0; ks < 4; ++ks) qr[ks] = *(const bf16x8*)(qp + 16 * ks); }
    const float* gp = WSP(float, WS_GATES) + (rowbase + t) * 48 + g * 4 + i;
    const float gate_c = gp[0], gate_s = gp[16], gate_w = gp[32];
    __syncthreads();
    for (int x = tid; x < 64 * 64; x += NTHR) IA[x] = 0.f;
    for (int x = tid; x < 64 * 65; x += NTHR) IB[x] = 0.f;
    f32x16 acc[2]; acc[0] = (f32x16){}; acc[1] = (f32x16){};
    f32x16 o[2], p0, p1;
    const float NEG = -INFINITY;
    const int ntc = (4 * qb + 3 + 63) >> 6;
    float m = -1e30f, l = 0.f;
    for (int jt = 0; jt < ntc; ++jt) {
        __syncthreads(); at_load_k(lds, kc + jt * 64 * 64, tid); __syncthreads();
        at_scores(p0, p1, lds, qr, c, h);
#pragma unroll
        for (int r = 0; r < 16; ++r) { const int d0 = t - (16 * (64 * jt + crow(r, h)) + 31), d1 = d0 - 512;
            p0[r] = d0 >= 0 ? p0[r] + LUT[min(d0, 4095) * 4 + i] : NEG; p1[r] = d1 >= 0 ? p1[r] + LUT[min(d1, 4095) * 4 + i] : NEG; }
        at_softmax(p0, p1, m, l, o, wsf, c, h, false);
    }
    { const float inv_l = l > 0.f ? 1.f / l : 0.f;
      o[0] = (f32x16){}; o[1] = (f32x16){};
      for (int jt = 0; jt < ntc; ++jt) {
        __syncthreads(); at_load_k(lds, kc + jt * 64 * 64, tid); at_load_vt(lds, vc + jt * 64 * 64, tid); __syncthreads();
        at_scores(p0, p1, lds, qr, c, h);
#pragma unroll
        for (int r = 0; r < 16; ++r) { const int d0 = t - (16 * (64 * jt + crow(r, h)) + 31), d1 = d0 - 512;
            p0[r] = d0 >= 0 ? __builtin_amdgcn_exp2f(p0[r] + LUT[min(d0, 4095) * 4 + i] - m) * inv_l : 0.f;
            p1[r] = d1 >= 0 ? __builtin_amdgcn_exp2f(p1[r] + LUT[min(d1, 4095) * 4 + i] - m) * inv_l : 0.f; }
#pragma unroll
        for (int sub = 0; sub < 2; ++sub)
#pragma unroll
            for (int gq = 0; gq < 4; ++gq) { const f32x16& p = sub ? p1 : p0;
                float pb = 0.5f * p[4 * gq + 3], pa = (p[4 * gq] + p[4 * gq + 1]) + (p[4 * gq + 2] + pb);
                pa += __shfl_xor(pa, 8); pa += __shfl_xor(pa, 16); pb += __shfl_xor(pb, 8); pb += __shfl_xor(pb, 16);
                const int s = 16 * jt + 8 * sub + 2 * gq + h;
                if (i == 0) { IA[q * 64 + s] = pa; IB[q * 65 + s + 1] = pb; } }
        at_pv(p0, p1, o, lds, c, h);
      }
      at_accum(acc, o, gate_c, wsf, c, h);
    }
    __syncthreads();
    { const int cur = qb; unsigned long long wor = 0ull;
      for (int qq = 0; qq < 8; ++qq) { const int q2 = 8 * w + qq;
          const bool forced = (lane == 0) || (lane == cur) || (lane == cur - 1);
          const float mine = forced ? INFINITY : IA[q2 * 64 + lane] + IB[q2 * 65 + lane];
          int rank = 0;
          for (int s2 = 0; s2 <= cur; ++s2) { const bool f2 = (s2 == 0) || (s2 == cur) || (s2 == cur - 1); const float ov = f2 ? INFINITY : IA[q2 * 64 + s2] + IB[q2 * 65 + s2];
              rank += (ov > mine || (ov == mine && s2 < lane)) ? 1 : 0; }
          const unsigned long long mask = __ballot(lane <= cur && rank < 16);
          if (lane == 0) { SEL[2 * q2] = (unsigned)mask; SEL[2 * q2 + 1] = (unsigned)(mask >> 32); }
          wor |= mask; }
      if (lane == 0) { WOR[2 * w] = (unsigned)wor; WOR[2 * w + 1] = (unsigned)(wor >> 32); } }
    __syncthreads();
    { unsigned long long uni = 0ull;
#pragma unroll
      for (int x = 0; x < 8; ++x) uni |= (unsigned long long)WOR[2 * x] | ((unsigned long long)WOR[2 * x + 1] << 32);
      const unsigned long long mysel = (unsigned long long)SEL[2 * q] | ((unsigned long long)SEL[2 * q + 1] << 32);
      m = -1e30f; l = 0.f; o[0] = (f32x16){}; o[1] = (f32x16){};
      for (int s = 0; s <= qb; ++s) {
        if (!((uni >> s) & 1ull)) continue;
        __syncthreads(); at_load_k(lds, ksp + (size_t)s * 64 * 64, tid); at_load_vt(lds, vsp + (size_t)s * 64 * 64, tid); __syncthreads();
        const bool rs = (mysel >> s) & 1ull;
        if (__ballot(rs) == 0ull) continue;
        at_scores(p0, p1, lds, qr, c, h);
#pragma unroll
        for (int r = 0; r < 16; ++r) { const int d0 = t - (64 * s + crow(r, h)), d1 = d0 - 32;
            p0[r] = (rs && d0 >= 0) ? p0[r] + LUT[max(d0, 0) * 4 + i] : NEG; p1[r] = (rs && d1 >= 0) ? p1[r] + LUT[max(d1, 0) * 4 + i] : NEG; }
        at_softmax(p0, p1, m, l, o, wsf, c, h, true);
        at_pv(p0, p1, o, lds, c, h);
      }
      at_accum(acc, o, l > 0.f ? gate_s / l : 0.f, wsf, c, h);
    }
    { m = -1e30f; l = 0.f; o[0] = (f32x16){}; o[1] = (f32x16){};
      for (int s = max(0, qb - 8); s <= qb; ++s) {
        __syncthreads(); at_load_k(lds, kwp + (size_t)s * 64 * 64, tid); at_load_vt(lds, vwp + (size_t)s * 64 * 64, tid); __syncthreads();
        at_scores(p0, p1, lds, qr, c, h);
#pragma unroll
        for (int r = 0; r < 16; ++r) { const int d0 = t - (64 * s + crow(r, h)), d1 = d0 - 32;
            p0[r] = (d0 >= 0 && d0 < 512) ? p0[r] + LUT[min(max(d0, 0), 4095) * 4 + i] : NEG; p1[r] = (d1 >= 0 && d1 < 512) ? p1[r] + LUT[min(max(d1, 0), 4095) * 4 + i] : NEG; }
        at_softmax(p0, p1, m, l, o, wsf, c, h, true);
        at_pv(p0, p1, o, lds, c, h);
      }
      at_accum(acc, o, l > 0.f ? gate_w / l : 0.f, wsf, c, h);
    }
    { bf16* AO = WSP(bf16, WS_AO);
#pragma unroll
      for (int r = 0; r < 16; ++r) { const int cc = crow(r, h), i2 = cc >> 3, t2 = t0 + 8 * w + (cc & 7); bf16* op = AO + (rowbase + t2) * DM + (g * 4 + i2) * 64 + c;
          op[0] = tobf(acc[0][r]); op[32] = tobf(acc[1][r]); } }
}
__device__ __forceinline__ void attn_phase(Frame& F) {
    LAS float* LUT = (LAS float*)(F.lds + AT_LUT); const int* bucket = WSP(int, WS_BUCKET); const float* rb = F.in[19];
    int curg = -1;
    for (int u = F.vcu; u < 2048; u += F.G) {
        const int v = u & 255, k = u >> 8, g = v >> 6, j = v & 63, a = j >> 3, rp = j & 7;
        const int b = (a + k) & 7, base = 16 * (k >> 1), qb = (k & 1) ? base + 15 - rp : base + rp;
        if (g != curg) { __syncthreads();
            for (int x = F.tid; x < 16384; x += NTHR) LUT[x] = rb[bucket[x >> 2] * 16 + g * 4 + (x & 3)] * LOG2E;
            __syncthreads(); curg = g; }
        attn_unit(F, b, g, qb);
    }
}

constexpr int NPHASE = 19;
struct Args { const float* in[24]; float* out; unsigned char* ws; int ph_lo, ph_hi, li, pad; };
__global__ void __launch_bounds__(NTHR, 2) fwd_kernel(Args args) {
    extern __shared__ __attribute__((aligned(16))) unsigned char lds_raw[];
    Frame F;
    F.lds = (LAS unsigned char*)lds_raw;
    F.tid = threadIdx.x; F.lane = F.tid & 63; F.wave = __builtin_amdgcn_readfirstlane(F.tid >> 6);
    F.G = gridDim.x; { const int bx = blockIdx.x; F.vcu = (F.G % 8 == 0) ? (bx % 8) * (F.G / 8) + bx / 8 : bx; }
    F.in = args.in; F.out = args.out; F.ws = args.ws;
    const int lo = args.ph_lo, hi = args.ph_hi;
#ifdef PH_MASK
#define IN(k) ((((PH_MASK) >> (k)) & 1) && lo <= (k) && (k) < hi)
#else
#define IN(k) (lo <= (k) && (k) < hi)
#endif
#define SEAM(k) do { if (IN(k) && IN((k) + 1)) { cg::this_grid().sync(); } asm volatile("" : "+v"(F.tid)); F.lane = F.tid & 63; F.wave = __builtin_amdgcn_readfirstlane(F.tid >> 6); } while (0)
    float* MOD = WSP(float, WS_MOD); float* SSQ = WSP(float, WS_SSQ);
    if (IN(0)) { p0a(F); } SEAM(0);
    if (IN(1)) { p0b(F); } SEAM(1);
    if (IN(2)) {
        pg8::Gemm g{WSP(bf16, WS_XS), WSP(bf16, WS_W_ABIN), MTOK, ABN, 1024, 1024}; pg8::StaticOrder S; S.init(MTOK, ABN, F.G, (int)blockIdx.x);
        EpiAbIn E{SSQ, WSP(float, WS_BV_ABIN), WSP(float, WS_LB), WSP(bf16, WS_QH), WSP(bf16, WS_IV), WSP(bf16, WS_GS), WSP(bf16, WS_GB), WSP(bf16, WS_GC), WSP(bf16, WS_SV), WSP(float, WS_LF)};
        pg8::gemm_phase<EpiAbIn, pg8::StaticOrder, true, true>(F.lds, g, S, E, F.tid);
    } SEAM(2);
    if (IN(3)) { for (int u = F.vcu; u < 2048; u += F.G) hgrn_s1_unit(F, u); sconv_pass(F); } SEAM(3);
    if (IN(4)) { hgrn_s2(F); } SEAM(4);
    if (IN(5)) { for (int u = F.vcu; u < 2048; u += F.G) hgrn_s3_unit(F, u); } SEAM(5);
    if (IN(6)) {
        pg8::Gemm g{WSP(bf16, WS_AO), WSP(bf16, WS_W_ABOUT), MTOK, 1024, 1024, 1024}; pg8::StaticOrder S; S.init(MTOK, 1024, F.G, (int)blockIdx.x);
        EpiRes E{F.in[0], F.out, WSP(bf16, WS_XS), MOD + 2048, F.in[5], MOD + 4096, SSQ, 1};
        pg8::gemm_phase<EpiRes, pg8::StaticOrder, true, true>(F.lds, g, S, E, F.tid);
    } SEAM(6);
    for (int l = 0; l < 2; ++l) {
        const int p = l == 0 ? 7 : 15;
        if (IN(p)) {
            pg8::Gemm g{WSP(bf16, WS_XS), WSP(bf16, WS_W_UP) + (size_t)l * UPN * 1024, MTOK, UPN, 1024, 1024}; pg8::StaticOrder S; S.init(MTOK, UPN, F.G, (int)blockIdx.x);
            EpiUp E{SSQ, WSP(float, l ? WS_BV_UP1 : WS_BV_UP0), WSP(bf16, WS_G), WSP(bf16, WS_UP)};
            pg8::gemm_phase<EpiUp, pg8::StaticOrder, true, true>(F.lds, g, S, E, F.tid);
        } SEAM(p);
        if (IN(p + 1)) { convact_pass(F, F.in[21] + (size_t)l * 3 * DFF); } SEAM(p + 1);
        if (IN(p + 2)) {
            pg8::Gemm g{WSP(bf16, WS_UP), WSP(bf16, WS_W_DOWN) + (size_t)l * 1024 * DFF, MTOK, 1024, DFF, DFF}; pg8::StaticOrder S; S.init(MTOK, 1024, F.G, (int)blockIdx.x);
            EpiRes E{F.out, F.out, WSP(bf16, WS_XS), MOD + l * 8 * 6144 + 5120, F.in[4] + 1024, MOD + 8 * 6144 + 1024, SSQ, l == 0 ? 1 : 0};
            pg8::gemm_phase<EpiRes, pg8::StaticOrder, true, true>(F.lds, g, S, E, F.tid);
        } SEAM(p + 2);
        if (l == 1) break;
        if (IN(10)) {
            pg8::Gemm g{WSP(bf16, WS_XS), WSP(bf16, WS_W_NSAIN), MTOK, NSAN, 1024, 1024}; pg8::StaticOrder S; S.init(MTOK, NSAN, F.G, (int)blockIdx.x);
            EpiNsaIn E{SSQ, WSP(float, WS_BV_NSA), WSP(bf16, WS_QN), WSP(bf16, WS_KV6), WSP(float, WS_GATES)};
            pg8::gemm_phase<EpiNsaIn, pg8::StaticOrder, true, true>(F.lds, g, S, E, F.tid);
        } SEAM(10);
        if (IN(11)) {
#pragma unroll 1
            for (int which = 0; which < 2; ++which) {
                pg8::Gemm g{WSP(bf16, WS_KV6) + (size_t)which * BATCH * 4 * KVPANEL, WSP(bf16, WS_W_CMP1) + (size_t)which * 256 * 2048, 8192, 256, 2048, 1024};
                OffsetOrder S; S.init(8192, 256, F.G, (int)blockIdx.x, which * 32);
                EpiCmp1 E{WSP(float, WS_CMPB) + which * 256, WSP(bf16, WS_HID) + (size_t)which * 8192 * 256};
                pg8::gemm_phase<EpiCmp1, OffsetOrder, true, true>(F.lds, g, S, E, F.tid);
            }
        } SEAM(11);
        if (IN(12)) { cmp2_pass(F); } SEAM(12);
        if (IN(13)) { attn_phase(F); } SEAM(13);
        if (IN(14)) {
            pg8::Gemm g{WSP(bf16, WS_AO), WSP(bf16, WS_W_NSAOUT), MTOK, 1024, 1024, 1024}; pg8::StaticOrder S; S.init(MTOK, 1024, F.G, (int)blockIdx.x);
            EpiRes E{F.out, F.out, WSP(bf16, WS_XS), MOD + 8 * 6144 + 2048, F.in[5] + 1024, MOD + 8 * 6144 + 4096, SSQ, 1};
            pg8::gemm_phase<EpiRes, pg8::StaticOrder, true, true>(F.lds, g, S, E, F.tid);
        } SEAM(14);
    }
    if (IN(18)) { final_pass(F); }
#undef IN
#undef SEAM
}

#ifndef MK_SINGLE
#define MK_SINGLE 1
#endif
extern "C" void kernel_launch(void* const* d_in, const int* in_sizes, int n_in, void* d_out, int out_size, void* d_ws, size_t ws_size, hipStream_t stream) {
    static int grid = 0;
    if (grid == 0) {
        if (n_in != 24 || in_sizes[0] != MTOK * DM || out_size != MTOK * DM || ws_size < WS_END) { fprintf(stderr, "kernel_launch: unexpected shapes (n_in %d, in0 %d, out %d, ws %zu)\n", n_in, n_in > 0 ? in_sizes[0] : -1, out_size, ws_size); grid = -1; return; }
        int dev = 0, cus = 0, per_cu = 0;
        if (hipGetDevice(&dev) != hipSuccess || hipDeviceGetAttribute(&cus, hipDeviceAttributeMultiprocessorCount, dev) != hipSuccess) { grid = -1; return; }
        if (hipFuncSetAttribute((const void*)fwd_kernel, hipFuncAttributeMaxDynamicSharedMemorySize, LDS_BYTES) != hipSuccess) { fprintf(stderr, "kernel_launch: hipFuncSetAttribute failed\n"); grid = -1; return; }
        if (hipOccupancyMaxActiveBlocksPerMultiprocessor(&per_cu, (const void*)fwd_kernel, NTHR, LDS_BYTES) != hipSuccess || per_cu < 1) { fprintf(stderr, "kernel_launch: occupancy query gives %d\n", per_cu); per_cu = 1; }
        (void)hipGetLastError();
        grid = cus;
    }
    if (grid < 0) return;
    (void)hipMemsetAsync((char*)d_ws + WS_CTL, 0, CTL_ZERO_BYTES, stream);
    Args a{};
    for (int i = 0; i < 24; ++i) a.in[i] = (const float*)d_in[i];
    a.out = (float*)d_out; a.ws = (unsigned char*)d_ws;
#if MK_SINGLE
    a.ph_lo = 0; a.ph_hi = NPHASE; a.li = 0;
    void* kargs[] = {&a};
    hipError_t e = hipLaunchCooperativeKernel((const void*)fwd_kernel, dim3(grid), dim3(NTHR), kargs, LDS_BYTES, stream);
    if (e != hipSuccess) fprintf(stderr, "kernel_launch: cooperative launch failed: %s (grid %d)\n", hipGetErrorString(e), grid);
#else
    for (int p = 0; p < NPHASE; ++p) { a.ph_lo = p; a.ph_hi = p + 1; a.li = p; hipLaunchKernelGGL(fwd_kernel, dim3(grid), dim3(NTHR), LDS_BYTES, stream, a); }
#endif
}
```

```cpp
#include <hip/hip_runtime.h>
#include <hip/hip_cooperative_groups.h>
#include <cstdio>
#include <cstdint>
namespace cg = cooperative_groups;
namespace pg8 {
#define PG8_LAS __attribute__((address_space(3)))
typedef unsigned short bf16_t;
typedef short bf16x8 __attribute__((ext_vector_type(8)));
typedef float f32x4 __attribute__((ext_vector_type(4)));
typedef unsigned u32x4 __attribute__((ext_vector_type(4)));
constexpr int BM = 256, BK = 64, HALF = 128, HTB = HALF * BK * 2  , STAGE_BYTES = 8 * HTB, NXCD = 8, WGM = 8;

__host__ __device__ __forceinline__ int lds_byte(int r, int c) { const int st = (r >> 4) * 2 + (c >> 5), rr = r & 15, cc = c & 31, ob = rr * 64 + cc * 2; return st * 1024 + (ob ^ (((ob >> 9) & 1) << 5)); }
__host__ __device__ __forceinline__ void stage_rc(int b, int& R, int& C) { const int st = b / 1024, sb = b % 1024, swz = sb ^ (((sb >> 9) & 1) << 5); R = (st >> 1) * 16 + swz / 64; C = (st & 1) * 32 + (swz % 64) / 2; }
__host__ __device__ __forceinline__ int perm32(int rho) { const int n = rho >> 4, i = rho & 15; return 8 * (i >> 2) + 4 * n + (i & 3); }

struct Unit { int pm, pn; };
struct Gemm { const bf16_t* A; const bf16_t* Bt; int M, N, K, lda; };

struct StaticOrder {
    int nM, nN, nwg, G, c;
    __host__ __device__ void init(int M, int N, int G_, int c_) { nM = M / BM; nN = N / BM; nwg = nM * nN; G = G_; c = c_; }
    __host__ __device__ bool next(int i, Unit& u) const {
        const long L = (long)i * G + c; if (L >= nwg) return false;
        int wgid = (int)L; { const int q = nwg / NXCD, r = nwg % NXCD, xcd = wgid % NXCD, off = wgid / NXCD; wgid = (xcd < r ? xcd * (q + 1) : r * (q + 1) + (xcd - r) * q) + off; }
        const int nig = WGM * nN, gid = wgid / nig, fm = gid * WGM, gsz = (nM - fm) < WGM ? (nM - fm) : WGM;
        u.pm = fm + ((wgid % nig) % gsz); u.pn = (wgid % nig) / gsz; return true;
    }
    __device__ __forceinline__ void a_ready(const Unit&) const {}
    __device__ __forceinline__ void done(const Unit&) const {}
};

template <class Epi, class Sched, bool ALIGN_EPI = false, bool SP2 = false>
__device__ __forceinline__ void gemm_phase(PG8_LAS unsigned char* lds, const Gemm g, const Sched& S, const Epi& E, int tid_in) {
    const int tid = tid_in, wid = __builtin_amdgcn_readfirstlane(tid >> 6), lane = tid & 63, wr = wid >> 2, wc = wid & 3, fr = lane & 15, fq = lane >> 4;
    const int K = g.K, nt = K / BK;
    unsigned voffA[2], voffB[2];
#pragma unroll
    for (int i = 0; i < 2; ++i) { int R, C; stage_rc(tid * 16 + i * 8192, R, C); const int Rb = Epi::PERM ? ((R & ~31) + perm32(R & 31)) : R;
        voffA[i] = (unsigned)(R * g.lda + C) * 2u; voffB[i] = (unsigned)(Rb * K + C) * 2u; }
    const size_t kstep = (size_t)(BK * 2);
    const size_t hstepA = (size_t)HALF * g.lda * 2, hstepB = (size_t)HALF * K * 2;
    const size_t tstepA = 2 * hstepA, tstepB = 2 * hstepB;
    const unsigned ldsw = (unsigned)wid * 1024u;
    const int aoff = lds_byte(wr * 64 + fr, fq * 8), boff = lds_byte(wc * 32 + fr, fq * 8);
#define PG8_SA(b, h) (((b) * 2 + (h)) * HTB)
#define PG8_SB(b, h) ((4 + (b) * 2 + (h)) * HTB)
#define PG8_STAGE(bufoff, gbase, voff) do { _Pragma("unroll") for (int _i = 0; _i < 2; ++_i) \
        __builtin_amdgcn_global_load_lds((const unsigned*)((const char*)(gbase) + (voff)[_i]), (PG8_LAS unsigned*)(lds + (bufoff) + ldsw + _i * 8192), 16, 0, 0); } while (0)
#define PG8_LDA(dst, b, h) do { _Pragma("unroll") for (int m = 0; m < 4; ++m) _Pragma("unroll") for (int k = 0; k < 2; ++k) dst[m][k] = *(const PG8_LAS bf16x8*)(lds + PG8_SA(b, h) + aoff + m * 2048 + k * 1024); } while (0)
#define PG8_LDB(dst, b, h) do { _Pragma("unroll") for (int n = 0; n < 2; ++n) _Pragma("unroll") for (int k = 0; k < 2; ++k) dst[n][k] = *(const PG8_LAS bf16x8*)(lds + PG8_SB(b, h) + boff + n * 2048 + k * 1024); } while (0)
#define PG8_MMA(ai, bj, At, Bt) do { __builtin_amdgcn_s_setprio(1); _Pragma("unroll") for (int m = 0; m < 4; ++m) _Pragma("unroll") for (int n = 0; n < 2; ++n) _Pragma("unroll") for (int k = 0; k < 2; ++k) \
        acc[ai][bj][m][n] = __builtin_amdgcn_mfma_f32_16x16x32_bf16(Bt[n][k], At[m][k], acc[ai][bj][m][n], 0, 0, 0); __builtin_amdgcn_s_setprio(0); } while (0)
#define PG8_WAIT_V(n) asm volatile("s_waitcnt vmcnt(" #n ")" ::: "memory")
#define PG8_WAIT_L(n) asm volatile("s_waitcnt lgkmcnt(" #n ")" ::: "memory")
#define PG8_BAR __builtin_amdgcn_s_barrier()
#define PG8_SCHED __builtin_amdgcn_sched_barrier(0)
    Unit cur, nxt; int ui = 0;
    if (!S.next(0, cur)) return;
    f32x4 acc[2][2][4][2];
#pragma unroll
    for (int a = 0; a < 2; ++a)
#pragma unroll
        for (int b = 0; b < 2; ++b)
#pragma unroll
            for (int m = 0; m < 4; ++m)
#pragma unroll
                for (int n = 0; n < 2; ++n) acc[a][b][m][n] = (f32x4){0.f, 0.f, 0.f, 0.f};
    bf16x8 At[4][2], B0[2][2], B1[2][2];
    const char* cA = (const char*)g.A + (size_t)cur.pm * tstepA; const char* cB = (const char*)g.Bt + (size_t)cur.pn * tstepB;
    S.a_ready(cur);
    if constexpr (SP2) {
        PG8_STAGE(PG8_SB(0, 0), cB, voffB); PG8_STAGE(PG8_SB(0, 1), cB + hstepB, voffB); PG8_STAGE(PG8_SA(0, 0), cA, voffA); PG8_STAGE(PG8_SA(0, 1), cA + hstepA, voffA);
        if (wr == 1) PG8_BAR;
        PG8_WAIT_V(2); PG8_BAR;
        PG8_STAGE(PG8_SB(1, 0), cB + kstep, voffB); PG8_STAGE(PG8_SA(1, 0), cA + kstep, voffA); PG8_STAGE(PG8_SB(1, 1), cB + hstepB + kstep, voffB);
        PG8_WAIT_V(6); PG8_BAR;
    } else {
        PG8_STAGE(PG8_SB(0, 0), cB, voffB); PG8_STAGE(PG8_SA(0, 0), cA, voffA); PG8_STAGE(PG8_SB(0, 1), cB + hstepB, voffB); PG8_STAGE(PG8_SA(0, 1), cA + hstepA, voffA);
        if (wr == 1) PG8_BAR;
        PG8_WAIT_V(4); PG8_BAR;
        PG8_STAGE(PG8_SB(1, 0), cB + kstep, voffB); PG8_STAGE(PG8_SA(1, 0), cA + kstep, voffA); PG8_STAGE(PG8_SB(1, 1), cB + hstepB + kstep, voffB);
        PG8_WAIT_V(6); PG8_BAR;
    }
    for (;;) {
        const bool has_next = S.next(ui + 1, nxt);
        const char* nA = has_next ? (const char*)g.A + (size_t)nxt.pm * tstepA : cA; const char* nB = has_next ? (const char*)g.Bt + (size_t)nxt.pn * tstepB : cB;
        for (int t = 0; t < nt; t += 2) {
            const bool last = (t == nt - 2);
            const char* a1 = cA + (size_t)(t + 1) * kstep;
            const char* a2 = last ? nA : cA + (size_t)(t + 2) * kstep; const char* b2 = last ? nB : cB + (size_t)(t + 2) * kstep;
            const char* a3 = a2 + kstep; const char* b3 = b2 + kstep;
            if (last && has_next) S.a_ready(nxt);
            if constexpr (SP2) {
            PG8_LDB(B0, 0, 0); PG8_LDB(B1, 0, 1); PG8_SCHED; PG8_LDA(At, 0, 0); PG8_STAGE(PG8_SA(1, 1), a1 + hstepA, voffA);
            PG8_WAIT_V(8); PG8_WAIT_L(0); PG8_BAR; PG8_MMA(0, 0, At, B0); PG8_MMA(0, 1, At, B1); PG8_BAR; PG8_SCHED;
            PG8_LDA(At, 0, 1); PG8_STAGE(PG8_SB(0, 0), b2, voffB); PG8_STAGE(PG8_SB(0, 1), b2 + hstepB, voffB); PG8_STAGE(PG8_SA(0, 0), a2, voffA);
            PG8_WAIT_V(8); PG8_WAIT_L(0); PG8_BAR; PG8_MMA(1, 0, At, B0); PG8_MMA(1, 1, At, B1); PG8_BAR; PG8_SCHED;
            PG8_LDB(B0, 1, 0); PG8_LDB(B1, 1, 1); PG8_SCHED; PG8_LDA(At, 1, 0); PG8_STAGE(PG8_SA(0, 1), a2 + hstepA, voffA);
            PG8_WAIT_V(8); PG8_WAIT_L(0); PG8_BAR; PG8_MMA(0, 0, At, B0); PG8_MMA(0, 1, At, B1); PG8_BAR; PG8_SCHED;
            PG8_LDA(At, 1, 1); PG8_STAGE(PG8_SB(1, 0), b3, voffB); PG8_STAGE(PG8_SB(1, 1), b3 + hstepB, voffB); PG8_STAGE(PG8_SA(1, 0), a3, voffA);
            PG8_WAIT_V(8); PG8_WAIT_L(0); PG8_BAR; PG8_MMA(1, 0, At, B0); PG8_MMA(1, 1, At, B1); PG8_BAR; PG8_SCHED;
            } else {
            PG8_LDB(B0, 0, 0); PG8_SCHED; PG8_LDA(At, 0, 0); PG8_STAGE(PG8_SA(1, 1), a1 + hstepA, voffA);
            PG8_WAIT_L(8); PG8_BAR; PG8_WAIT_L(0); PG8_MMA(0, 0, At, B0); PG8_BAR; PG8_SCHED;
            PG8_LDB(B1, 0, 1); PG8_STAGE(PG8_SB(0, 0), b2, voffB);
            PG8_BAR; PG8_WAIT_L(0); PG8_MMA(0, 1, At, B1); PG8_BAR;
            PG8_LDA(At, 0, 1); PG8_STAGE(PG8_SA(0, 0), a2, voffA);
            PG8_BAR; PG8_WAIT_L(0); PG8_MMA(1, 0, At, B0); PG8_BAR; PG8_SCHED;
            PG8_STAGE(PG8_SB(0, 1), b2 + hstepB, voffB);
            PG8_WAIT_V(6); PG8_BAR; PG8_MMA(1, 1, At, B1); PG8_BAR;
            PG8_LDB(B0, 1, 0); PG8_SCHED; PG8_LDA(At, 1, 0); PG8_STAGE(PG8_SA(0, 1), a2 + hstepA, voffA);
            PG8_WAIT_L(8); PG8_BAR; PG8_WAIT_L(0); PG8_MMA(0, 0, At, B0); PG8_BAR; PG8_SCHED;
            PG8_LDB(B1, 1, 1); PG8_STAGE(PG8_SB(1, 0), b3, voffB);
            PG8_BAR; PG8_WAIT_L(0); PG8_MMA(0, 1, At, B1); PG8_BAR;
            PG8_LDA(At, 1, 1); PG8_STAGE(PG8_SA(1, 0), a3, voffA);
            PG8_BAR; PG8_WAIT_L(0); PG8_MMA(1, 0, At, B0); PG8_BAR; PG8_SCHED;
            PG8_STAGE(PG8_SB(1, 1), b3 + hstepB, voffB);
            PG8_WAIT_V(6); PG8_BAR; PG8_MMA(1, 1, At, B1); PG8_BAR;
            }
        }
        if constexpr (ALIGN_EPI) { if (wr == 0) PG8_BAR; }
        if constexpr (!Epi::AFTER_DRAIN) { E(acc, cur, wr, wc, fr, fq); S.done(cur); }
        if (!has_next) break;
#pragma unroll
        for (int a = 0; a < 2; ++a)
#pragma unroll
            for (int b = 0; b < 2; ++b)
#pragma unroll
                for (int m = 0; m < 4; ++m)
#pragma unroll
                    for (int n = 0; n < 2; ++n) acc[a][b][m][n] = (f32x4){0.f, 0.f, 0.f, 0.f};
        cur = nxt; cA = nA; cB = nB; ++ui;
        if constexpr (ALIGN_EPI) { if (wr == 1) PG8_BAR; }
    }
    PG8_WAIT_V(0);
    if constexpr (!ALIGN_EPI) { if (wr == 0) PG8_BAR; }
    PG8_BAR;
    if constexpr (Epi::AFTER_DRAIN) { E.fused(acc, cur, wr, wc, fr, fq, lds, wid, lane); S.done(cur); }
#undef PG8_SA
#undef PG8_SB
#undef PG8_STAGE
#undef PG8_LDA
#undef PG8_LDB
#undef PG8_MMA
#undef PG8_WAIT_V
#undef PG8_WAIT_L
#undef PG8_BAR
#undef PG8_SCHED
}
}
#define GAS __attribute__((address_space(1)))
#define LAS __attribute__((address_space(3)))
typedef unsigned short bf16;
typedef unsigned v4u __attribute__((ext_vector_type(4)));
typedef float f32x4 __attribute__((ext_vector_type(4)));
typedef short bf16x8 __attribute__((ext_vector_type(8)));
typedef GAS unsigned gu32;
typedef GAS unsigned long long gu64;
#define RLX_AGENT __ATOMIC_RELAXED, __HIP_MEMORY_SCOPE_AGENT
#define LDS_WAIT() asm volatile("s_waitcnt lgkmcnt(0)" ::: "memory")
#define VM_WAIT() asm volatile("s_waitcnt vmcnt(0)" ::: "memory")
__device__ __forceinline__ unsigned long long rt() { return __builtin_amdgcn_s_memrealtime(); }
__device__ __forceinline__ unsigned f2bf(float f) { unsigned u = __builtin_bit_cast(unsigned, f); return (u + 0x7fffu + ((u >> 16) & 1u)) >> 16; }
__device__ __forceinline__ unsigned pk2(float lo, float hi) { return f2bf(lo) | (f2bf(hi) << 16); }

#define XB_TMO      128
#define XB_XCNT(j)  (256  + 64 * (j))
#define XB_XSUB(j)  (1280 + 64 * (j))
#define XB_XGEN(j)  (2304 + 64 * (j))
#define XB_TOP      3328
#define XB_TOPGEN   3392
#define XCD_BAR_WORDS 3456
#define XB_SPIN_CAP (1u << 18)

__device__ __forceinline__ unsigned xb_ld(unsigned* p)              { return __hip_atomic_load(p, __ATOMIC_RELAXED, __HIP_MEMORY_SCOPE_AGENT); }
__device__ __forceinline__ unsigned xb_add(unsigned* p, unsigned v) { return __hip_atomic_fetch_add(p, v, __ATOMIC_RELAXED, __HIP_MEMORY_SCOPE_AGENT); }
__device__ __forceinline__ unsigned xb_xcc_id() { return (unsigned)__builtin_amdgcn_s_getreg((3 << 11) | 20) & 0xFu; }
#define XB_SPIN(cond, bar) do { unsigned _sp = 0; while (cond) { __builtin_amdgcn_s_sleep(1); \
    if ((++_sp & 255u) == 0u) { if (xb_ld(&(bar)[XB_TMO])) break; if (_sp > XB_SPIN_CAP) { atomicAdd(&(bar)[XB_TMO], 1u); break; } } } } while (0)

struct XcdBarrier {
    unsigned* bar; unsigned x;
    volatile LAS unsigned* st;
};

__device__ __forceinline__ XcdBarrier xcd_barrier_post(unsigned* bar, volatile LAS unsigned* st) {
    XcdBarrier b; b.bar = bar; b.x = xb_xcc_id(); b.st = st;
    if (threadIdx.x == 0) (void)xb_add(&bar[XB_XCNT(b.x)], 1u);
    return b;
}
__device__ __forceinline__ void xcd_barrier_complete(unsigned* bar, unsigned x, unsigned& nloc, unsigned& nx) {
    const unsigned G = gridDim.x * gridDim.y * gridDim.z;
    unsigned sum, cnt, mine, sp = 0u;
    for (;;) {
        sum = 0u; cnt = 0u; mine = 0u;
#pragma unroll
        for (unsigned j = 0; j < 16; ++j) { const unsigned c = xb_ld(&bar[XB_XCNT(j)]); sum += c; cnt += (c > 0u) ? 1u : 0u; mine = (j == x) ? c : mine; }
        if (sum == G) break;
        __builtin_amdgcn_s_sleep(1);
        if ((++sp & 255u) == 0u) { if (xb_ld(&bar[XB_TMO])) break; if (sp > XB_SPIN_CAP) { atomicAdd(&bar[XB_TMO], 1u); break; } }
    }
    nloc = mine > 0u ? mine : 1u; nx = cnt > 0u ? cnt : 1u;
}

__device__ __forceinline__ void xcd_barrier(const XcdBarrier& b) {
    asm volatile("s_waitcnt vmcnt(0)" ::: "memory");
    __syncthreads();
    if (threadIdx.x == 0) {
        unsigned* bar = b.bar;
        __builtin_amdgcn_s_waitcnt(0);
        unsigned nloc = b.st[0], nx = b.st[1];
        if (nloc == 0u) { xcd_barrier_complete(bar, b.x, nloc, nx); b.st[0] = nloc; b.st[1] = nx; }
        const unsigned old = xb_add(&bar[XB_XSUB(b.x)], 1u);
        const unsigned gen = old / nloc;
        if (old + 1u == (gen + 1u) * nloc) {
            __builtin_amdgcn_fence(__ATOMIC_RELEASE, "agent");
            asm volatile("s_waitcnt vmcnt(0)" ::: "memory");
            const unsigned og = xb_add(&bar[XB_TOP], 1u);
            const unsigned tg = og / nx;
            if (og + 1u == (tg + 1u) * nx) xb_add(&bar[XB_TOPGEN], 1u);
            else XB_SPIN(xb_ld(&bar[XB_TOPGEN]) == tg, bar);
            __builtin_amdgcn_fence(__ATOMIC_ACQUIRE, "agent");
            xb_add(&bar[XB_XGEN(b.x)], 1u);
            asm volatile("s_waitcnt vmcnt(0)" ::: "memory");
        } else {
            XB_SPIN(xb_ld(&bar[XB_XGEN(b.x)]) == gen, bar);
            __builtin_amdgcn_fence(__ATOMIC_ACQUIRE, "agent");
            asm volatile("s_waitcnt vmcnt(0)" ::: "memory");
        }
    }
    __syncthreads();
}

constexpr int NWAVES = 8, NTHR = 512;
constexpr int BATCH = 8, SEQ = 4096, DM = 1024, MTOK = BATCH * SEQ;
constexpr int HGW = 512, ABN = 3584, DFF = 2816, UPN = 5632, NSAN = 2816;
constexpr float EPSN = 1e-6f;
constexpr float LOG2E = 1.4426950408889634f;
constexpr float QSCALE = 0.125f * LOG2E;

constexpr size_t MiB = (size_t)1 << 20;
constexpr size_t WS_CTL = 0, CTL_ZERO_BYTES = 1 * MiB;
constexpr size_t WS_MOD = 1 * MiB;
constexpr size_t WS_BV_ABIN = WS_MOD + 393216;
constexpr size_t WS_BV_UP0 = WS_BV_ABIN + 114688;
constexpr size_t WS_BV_NSA = WS_BV_UP0 + 180224;
constexpr size_t WS_BV_UP1 = WS_BV_NSA + 90112;
constexpr size_t WS_LB = WS_BV_UP1 + 180224;
constexpr size_t WS_BUCKET = WS_LB + 2048;
constexpr size_t WS_CMPB = WS_BUCKET + 16384;
static_assert(WS_CMPB + 2048 <= 2 * MiB, "tables");
constexpr size_t WS_SSQ = 3 * MiB;
constexpr size_t WS_DB = 5 * MiB;
constexpr size_t WS_GATES = 6 * MiB;
constexpr size_t WS_W_ABIN = 12 * MiB, WS_W_ABOUT = 19 * MiB, WS_W_NSAIN = 21 * MiB, WS_W_NSAOUT = 27 * MiB;
constexpr size_t WS_W_UP = 29 * MiB, WS_W_DOWN = 51 * MiB, WS_W_CMP1 = 62 * MiB;
constexpr size_t WS_XS = 64 * MiB;
constexpr size_t WS_AO = 128 * MiB;
constexpr size_t WS_QH = 192 * MiB, WS_IV = 224 * MiB, WS_GS = 256 * MiB, WS_GB = 288 * MiB, WS_GC = 320 * MiB, WS_SV = 352 * MiB;
constexpr size_t WS_LF = 384 * MiB;
constexpr size_t WS_UB = 448 * MiB;
constexpr size_t WS_G = 128 * MiB, WS_UP = 304 * MiB;
constexpr size_t WS_QN = 192 * MiB;
constexpr size_t WS_KV6 = 256 * MiB;
constexpr size_t WS_HID = 352 * MiB;
constexpr size_t WS_KCMP = 360 * MiB, WS_VCMP = 361 * MiB;
constexpr size_t WS_END = 512 * MiB;
constexpr size_t KVPANEL = (size_t)SEQ * 64;

constexpr int RING_BYTES = 131072;
constexpr int LDS_BYTES = 147456;
constexpr int LDSCTL_OFF = RING_BYTES, MISC_OFF = LDSCTL_OFF + 320;
constexpr int CW_BAR = 4096;

__device__ __forceinline__ unsigned pkbf(float lo, float hi) {
    typedef float f2_t __attribute__((ext_vector_type(2))); typedef __bf16 b2_t __attribute__((ext_vector_type(2)));
    f2_t v = {lo, hi}; b2_t b = __builtin_convertvector(v, b2_t); return __builtin_bit_cast(unsigned, b);
}
__device__ __forceinline__ unsigned short tobf(float f) { return (unsigned short)(pkbf(f, 0.f) & 0xffffu); }
__device__ __forceinline__ float bflo(unsigned u) { return __uint_as_float(u << 16); }
__device__ __forceinline__ float bfhi(unsigned u) { return __uint_as_float(u & 0xffff0000u); }
__device__ __forceinline__ float bf2f(unsigned short u) { return __uint_as_float((unsigned)u << 16); }
__device__ __forceinline__ float sigmoid_f(float v) { return 1.f / (1.f + __expf(-v)); }
__device__ __forceinline__ float silu_f(float v) { return v / (1.f + __expf(-v)); }
__device__ __forceinline__ int crow(int reg, int h) { return (reg & 3) + 8 * (reg >> 2) + 4 * h; }
typedef float f32x16 __attribute__((ext_vector_type(16)));
typedef short s16x4 __attribute__((ext_vector_type(4)));
typedef unsigned u32x2 __attribute__((ext_vector_type(2)));
#define MFMA32(a, b, c) __builtin_amdgcn_mfma_f32_32x32x16_bf16((a), (b), (c), 0, 0, 0)
__device__ __forceinline__ float wave_sum(float v) {
#pragma unroll
    for (int o = 1; o < 64; o <<= 1) v += __shfl_xor(v, o);
    return v;
}

struct Frame {
    LAS unsigned char* lds;
    int tid, lane, wave, vcu, G;
    const float* const* in;
    float* out; unsigned char* ws;
};
#define WSP(T, off) ((T*)(F.ws + (off)))

__device__ __forceinline__ float row_rstd(const float* ssq, int row) {
    const f32x4* p = (const f32x4*)(ssq + (size_t)row * 16);
    const f32x4 a = p[0], b = p[1], c = p[2], d = p[3];
    const float s = ((a.x + a.y) + (a.z + a.w)) + ((b.x + b.y) + (b.z + b.w)) + ((c.x + c.y) + (c.z + c.w)) + ((d.x + d.y) + (d.z + d.w));
    return rsqrtf(s * (1.0f / DM) + EPSN);
}

#define EPI_LOOP_ROWS _Pragma("unroll") for (int ai = 0; ai < 2; ++ai) _Pragma("unroll") for (int m = 0; m < 4; ++m)
#define EPI_LOOP_COLS _Pragma("unroll") for (int bj = 0; bj < 2; ++bj) _Pragma("unroll") for (int n = 0; n < 2; ++n)

struct EpiAbIn {
    static constexpr bool PERM = false, AFTER_DRAIN = false;
    const float* ssq; const float* bv; const float* lb; bf16 *QH, *IV, *GS, *GB, *GC, *SV; float* LF;
    template <int SEG> __device__ __forceinline__ void emit(const f32x4 (&acc)[2][2][4][2], const pg8::Unit& u, int wr, int wc, int fr, int fq) const {
        const int cs0 = (u.pn & 1) * 256;
        EPI_LOOP_ROWS {
            const int row = u.pm * 256 + ai * 128 + wr * 64 + m * 16 + fr; const int b = row >> 12; const float rs = row_rstd(ssq, row);
            EPI_LOOP_COLS {
                const int cl = bj * 128 + wc * 32 + n * 16 + fq * 4, cs = cs0 + cl, cn = u.pn * 256 + cl;
                f32x4 v = acc[ai][bj][m][n] * rs + *(const f32x4*)(bv + b * ABN + cn);
                if (SEG == 1) {
                    const f32x4 l4 = *(const f32x4*)(lb + cs); f32x4 o;
#pragma unroll
                    for (int e = 0; e < 4; ++e) { const float fg = l4[e] + (1.f - l4[e]) * sigmoid_f(v[e]); o[e] = __logf(fg); }
                    *(f32x4*)(LF + (size_t)row * HGW + cs) = o;
                } else {
                    if (SEG == 3) {
#pragma unroll
                        for (int e = 0; e < 4; ++e) v[e] = silu_f(v[e]);
                    }
                    bf16* dst = SEG == 0 ? QH : SEG == 2 ? IV : SEG == 3 ? GS : SEG == 4 ? GB : SEG == 5 ? GC : SV;
                    u32x2 w; w.x = pkbf(v[0], v[1]); w.y = pkbf(v[2], v[3]);
                    *(u32x2*)(dst + (size_t)row * HGW + cs) = w;
                }
            }
        }
    }
    __device__ __forceinline__ void operator()(const f32x4 (&acc)[2][2][4][2], const pg8::Unit& u, int wr, int wc, int fr, int fq) const {
        switch (u.pn >> 1) {
            case 0: emit<0>(acc, u, wr, wc, fr, fq); break; case 1: emit<1>(acc, u, wr, wc, fr, fq); break; case 2: emit<2>(acc, u, wr, wc, fr, fq); break;
            case 3: emit<3>(acc, u, wr, wc, fr, fq); break; case 4: emit<4>(acc, u, wr, wc, fr, fq); break; case 5: emit<5>(acc, u, wr, wc, fr, fq); break;
            default: emit<6>(acc, u, wr, wc, fr, fq); break;
        }
    }
};

struct EpiRes {
    static constexpr bool PERM = false, AFTER_DRAIN = false;
    const float* xin; float* xout; bf16* xs; const float* gate; const float* ng; const float* nsc; float* ssq; int has_next;
    __device__ __forceinline__ void operator()(const f32x4 (&acc)[2][2][4][2], const pg8::Unit& u, int wr, int wc, int fr, int fq) const {
        EPI_LOOP_ROWS {
            const int row = u.pm * 256 + ai * 128 + wr * 64 + m * 16 + fr; const int b = row >> 12; float ss = 0.f;
            EPI_LOOP_COLS {
                const int cn = u.pn * 256 + bj * 128 + wc * 32 + n * 16 + fq * 4; const size_t off = (size_t)row * DM + cn;
                const f32x4 g4 = *(const f32x4*)(gate + b * 6144 + cn);
                const f32x4 xn = *(const f32x4*)(xin + off) + g4 * acc[ai][bj][m][n];
                *(f32x4*)(xout + off) = xn;
                ss += (xn[0] * xn[0] + xn[1] * xn[1]) + (xn[2] * xn[2] + xn[3] * xn[3]);
                if (has_next) {
                    const f32x4 n4 = *(const f32x4*)(ng + cn), s4 = *(const f32x4*)(nsc + b * 6144 + cn);
                    const f32x4 y = xn * (n4 * (1.f + s4));
                    u32x2 w; w.x = pkbf(y[0], y[1]); w.y = pkbf(y[2], y[3]);
                    *(u32x2*)(xs + off) = w;
                }
            }
            ss += __shfl_xor(ss, 16); ss += __shfl_xor(ss, 32);
            if (fq == 0) ssq[(size_t)row * 16 + u.pn * 4 + wc] = ss;
        }
    }
};

struct EpiUp {
    static constexpr bool PERM = false, AFTER_DRAIN = false;
    const float* ssq; const float* bv; bf16 *G, *UP;
    __device__ __forceinline__ void operator()(const f32x4 (&acc)[2][2][4][2], const pg8::Unit& u, int wr, int wc, int fr, int fq) const {
        bf16* dst = u.pn < 11 ? G : UP; const int c0 = (u.pn < 11 ? u.pn : u.pn - 11) * 256;
        EPI_LOOP_ROWS {
            const int row = u.pm * 256 + ai * 128 + wr * 64 + m * 16 + fr; const int b = row >> 12; const float rs = row_rstd(ssq, row);
            EPI_LOOP_COLS {
                const int cl = bj * 128 + wc * 32 + n * 16 + fq * 4;
                const f32x4 v = acc[ai][bj][m][n] * rs + *(const f32x4*)(bv + b * UPN + u.pn * 256 + cl);
                u32x2 w; w.x = pkbf(v[0], v[1]); w.y = pkbf(v[2], v[3]);
                *(u32x2*)(dst + (size_t)row * DFF + c0 + cl) = w;
            }
        }
    }
};

struct EpiNsaIn {
    static constexpr bool PERM = false, AFTER_DRAIN = false;
    const float* ssq; const float* bv; bf16* QN; bf16* KV6; float* GATES;
    __device__ __forceinline__ void operator()(const f32x4 (&acc)[2][2][4][2], const pg8::Unit& u, int wr, int wc, int fr, int fq) const {
        EPI_LOOP_ROWS {
            const int row = u.pm * 256 + ai * 128 + wr * 64 + m * 16 + fr; const int b = row >> 12, t = row & (SEQ - 1); const float rs = row_rstd(ssq, row);
            EPI_LOOP_COLS {
                const int cl = bj * 128 + wc * 32 + n * 16 + fq * 4;
                f32x4 v = acc[ai][bj][m][n] * rs + *(const f32x4*)(bv + b * NSAN + u.pn * 256 + cl);
                if (u.pn < 4) {
                    v = v * QSCALE; u32x2 w; w.x = pkbf(v[0], v[1]); w.y = pkbf(v[2], v[3]);
                    *(u32x2*)(QN + (size_t)row * DM + u.pn * 256 + cl) = w;
                } else if (u.pn < 10) {
                    const int idx = u.pn - 4, g = cl >> 6, d = cl & 63;
                    u32x2 w; w.x = pkbf(v[0], v[1]); w.y = pkbf(v[2], v[3]);
                    *(u32x2*)(KV6 + ((size_t)((idx * BATCH + b) * 4 + g)) * KVPANEL + (size_t)t * 64 + d) = w;
                } else if (cl < 48) {
                    f32x4 o;
#pragma unroll
                    for (int e = 0; e < 4; ++e) o[e] = sigmoid_f(v[e]);
                    *(f32x4*)(GATES + (size_t)row * 48 + cl) = o;
                }
            }
        }
    }
};

struct EpiCmp1 {
    static constexpr bool PERM = false, AFTER_DRAIN = false;
    const float* cb; bf16* HID;
    __device__ __forceinline__ void operator()(const f32x4 (&acc)[2][2][4][2], const pg8::Unit& u, int wr, int wc, int fr, int fq) const {
        EPI_LOOP_ROWS {
            const int row = u.pm * 256 + ai * 128 + wr * 64 + m * 16 + fr;
            EPI_LOOP_COLS {
                const int cl = bj * 128 + wc * 32 + n * 16 + fq * 4;
                const f32x4 v = acc[ai][bj][m][n] + *(const f32x4*)(cb + cl);
                u32x2 w; w.x = pkbf(silu_f(v[0]), silu_f(v[1])); w.y = pkbf(silu_f(v[2]), silu_f(v[3]));
                *(u32x2*)(HID + (size_t)row * 256 + cl) = w;
            }
        }
    }
};
struct OffsetOrder {
    int nM, nN, nwg, G, c;
    __device__ void init(int M_, int N_, int G_, int c_, int off) { nM = M_ / 256; nN = N_ / 256; nwg = nM * nN; G = G_; c = (c_ - off + 4 * G_) % G_; }
    __device__ bool next(int i, pg8::Unit& u) const { const long L = (long)i * G + c; if (L >= nwg) return false; u.pm = (int)L / nN; u.pn = (int)L % nN; return true; }
    __device__ __forceinline__ void a_ready(const pg8::Unit&) const {}
    __device__ __forceinline__ void done(const pg8::Unit&) const {}
};

__device__ __forceinline__ void transpose_item(const float* W, int K, int N, bf16* WT, int k0, int dst_row0, int src_col0, int nvalid, LAS float* scr, int lane) {
    const int j = lane & 31; const bool ok = j < nvalid;
#pragma unroll 8
    for (int i = 0; i < 32; ++i) { const int kk = 2 * i + (lane >> 5); scr[kk * 33 + j] = ok ? W[(size_t)(k0 + kk) * N + src_col0 + j] : 0.f; }
    LDS_WAIT(); asm volatile("" ::: "memory");
    const int c = lane & 7;
#pragma unroll
    for (int j4 = 0; j4 < 4; ++j4) { const int n = (lane >> 3) + 8 * j4; const LAS float* s = scr + (8 * c) * 33 + n;
        v4u o; o.x = pkbf(s[0 * 33], s[1 * 33]); o.y = pkbf(s[2 * 33], s[3 * 33]); o.z = pkbf(s[4 * 33], s[5 * 33]); o.w = pkbf(s[6 * 33], s[7 * 33]);
        *(v4u*)(WT + (size_t)(dst_row0 + n) * K + k0 + 8 * c) = o; }
    LDS_WAIT(); asm volatile("" ::: "memory");
}
__device__ __forceinline__ void nsa_colmap(int nb, int& src0, int& nv) {
    if (nb < 32) { src0 = 32 * nb; nv = 32; }
    else if (nb < 80) { src0 = 32 * nb + 48; nv = 32; }
    else if (nb == 80) { src0 = 1024; nv = 32; }
    else if (nb == 81) { src0 = 1056; nv = 16; }
    else { src0 = 0; nv = 0; }
}
template <class OutF> __device__ __forceinline__ void gemv8_item(const float* W, int ldw, int K, int src_col0, int nvalid, const LAS float* coef, LAS float* red, int tid, OutF out) {
    const int cl = tid & 31, kg = tid >> 5;
    float acc[8];
#pragma unroll
    for (int b = 0; b < 8; ++b) acc[b] = 0.f;
    const bool valid = cl < nvalid;
    const float* wp = W + (size_t)kg * ldw + src_col0 + cl;
#pragma unroll 8
    for (int kk = 0; kk < K / 16; ++kk) { const float w = valid ? wp[(size_t)kk * 16 * ldw] : 0.f; const int k = kg + 16 * kk;
#pragma unroll
        for (int b = 0; b < 8; ++b) acc[b] += coef[b * K + k] * w; }
#pragma unroll
    for (int b = 0; b < 8; ++b) red[(kg * 8 + b) * 32 + cl] = acc[b];
    __syncthreads();
    if (tid < 256) { const int b = tid >> 5; float s = 0.f;
#pragma unroll
        for (int k2 = 0; k2 < 16; ++k2) s += red[(k2 * 8 + b) * 32 + cl];
        out(b, cl, s); }
    __syncthreads();
}
constexpr int P0_TSCR = 0, P0_COEF = 69632, P0_RED = 102400;

__device__ __forceinline__ void p0a(Frame& F) {
    LAS float* coef = (LAS float*)(F.lds + P0_COEF); LAS float* red = (LAS float*)(F.lds + P0_RED);
    const float* c = F.in[1];
    for (int i = F.tid; i < 8 * 1024; i += NTHR) coef[i] = silu_f(c[i]);
    __syncthreads();
    float* MOD = WSP(float, WS_MOD);
    for (int it = F.vcu; it < 448; it += F.G) {
        if (it < 384) {
            const int l = it / 192, col0 = 32 * (it % 192); const float* mb = F.in[3] + l * 6144;
            gemv8_item(F.in[2] + (size_t)l * 1024 * 6144, 6144, 1024, col0, 32, coef, red, F.tid,
                       [&](int b, int cl, float s) { MOD[(l * 8 + b) * 6144 + col0 + cl] = s + mb[col0 + cl]; });
        } else {
            const int which = (it - 384) >> 5, kc = (it - 384) & 31; const float* pos = F.in[13 + which]; const float* w1 = F.in[which ? 17 : 15];
            const int n = F.tid & 255, hf = F.tid >> 8, kb = kc * 64 + hf * 32; float s = 0.f;
#pragma unroll 8
            for (int k = kb; k < kb + 32; ++k) s += pos[k] * w1[(size_t)k * 256 + n];
            red[hf * 256 + n] = s; __syncthreads();
            if (F.tid < 256) WSP(float, WS_DB)[((which * 32 + kc) << 8) + n] = red[n] + red[256 + n];
            __syncthreads();
        }
    }
    LAS float* scr = (LAS float*)(F.lds + P0_TSCR + F.wave * 8704);
    const int gw = F.vcu * NWAVES + F.wave, NGW = F.G * NWAVES;
    constexpr int I_ABIN = 16 * 112, I_ABOUT = 16 * 32, I_NSAIN = 16 * 88, I_NSAOUT = 16 * 32, I_UP = 16 * 176, I_DOWN = 44 * 32, I_CMP = 32 * 8;
    constexpr int NITEMS = I_ABIN + I_ABOUT + I_NSAIN + I_NSAOUT + 2 * I_UP + 2 * I_DOWN + 2 * I_CMP;
    for (int it = gw; it < NITEMS; it += NGW) {
        int r = it;
        if (r < I_ABIN) { transpose_item(F.in[6], 1024, ABN, WSP(bf16, WS_W_ABIN), 64 * (r / 112), 32 * (r % 112), 32 * (r % 112), 32, scr, F.lane); continue; } r -= I_ABIN;
        if (r < I_ABOUT) { transpose_item(F.in[7], 1024, 1024, WSP(bf16, WS_W_ABOUT), 64 * (r / 32), 32 * (r % 32), 32 * (r % 32), 32, scr, F.lane); continue; } r -= I_ABOUT;
        if (r < I_NSAIN) { int s0, nv; nsa_colmap(r % 88, s0, nv); transpose_item(F.in[11], 1024, 2608, WSP(bf16, WS_W_NSAIN), 64 * (r / 88), 32 * (r % 88), s0, nv, scr, F.lane); continue; } r -= I_NSAIN;
        if (r < I_NSAOUT) { transpose_item(F.in[12], 1024, 1024, WSP(bf16, WS_W_NSAOUT), 64 * (r / 32), 32 * (r % 32), 32 * (r % 32), 32, scr, F.lane); continue; } r -= I_NSAOUT;
        if (r < 2 * I_UP) { const int l = r / I_UP; r %= I_UP; transpose_item(F.in[20] + (size_t)l * 1024 * UPN, 1024, UPN, WSP(bf16, WS_W_UP) + (size_t)l * UPN * 1024, 64 * (r / 176), 32 * (r % 176), 32 * (r % 176), 32, scr, F.lane); continue; } r -= 2 * I_UP;
        if (r < 2 * I_DOWN) { const int l = r / I_DOWN; r %= I_DOWN; transpose_item(F.in[22] + (size_t)l * DFF * 1024, DFF, 1024, WSP(bf16, WS_W_DOWN) + (size_t)l * 1024 * DFF, 64 * (r / 32), 32 * (r % 32), 32 * (r % 32), 32, scr, F.lane); continue; } r -= 2 * I_DOWN;
        { const int which = r / I_CMP; r %= I_CMP; transpose_item(F.in[which ? 17 : 15], 2048, 256, WSP(bf16, WS_W_CMP1) + (size_t)which * 256 * 2048, 64 * (r / 8), 32 * (r % 8), 32 * (r % 8), 32, scr, F.lane); }
    }
    const int gt = F.vcu * NTHR + F.tid;
    if (gt < 4096) { int bk = gt; if (gt >= 16) { const float x = log2f((float)gt * 0.0625f) * 2.6666667f + 1e-5f; bk = 16 + (int)floorf(x); if (bk > 31) bk = 31; } WSP(int, WS_BUCKET)[gt] = bk; }
    if (gt < 512) { const float a = F.in[8][gt], b2 = F.in[8][512 + gt]; const float mx = fmaxf(a, b2); const float ea = __expf(a - mx), eb = __expf(b2 - mx); WSP(float, WS_LB)[gt] = ea / (ea + eb); }
}

__device__ __forceinline__ void p0b(Frame& F) {
    LAS float* coef = (LAS float*)(F.lds + P0_COEF); LAS float* red = (LAS float*)(F.lds + P0_RED);
    const float* MOD = WSP(float, WS_MOD);
    int curm = -1;
    for (int it = F.vcu; it < 552; it += F.G) {
        int mid, r = it;
        if (r < 112) mid = 0; else if ((r -= 112) < 176) mid = 1; else if ((r -= 176) < 88) mid = 2; else { r -= 88; mid = 3; }
        if (mid != curm) {
            __syncthreads();
            const int l = mid >> 1, off = (mid & 1) ? 3072 : 0;
            for (int i = F.tid; i < 8192; i += NTHR) coef[i] = MOD[(l * 8 + (i >> 10)) * 6144 + off + (i & 1023)];
            __syncthreads(); curm = mid;
        }
        if (mid == 0) { float* o = WSP(float, WS_BV_ABIN); gemv8_item(F.in[6], ABN, 1024, 32 * r, 32, coef, red, F.tid, [&](int b, int cl, float s) { o[b * ABN + 32 * r + cl] = s; }); }
        else if (mid == 1) { float* o = WSP(float, WS_BV_UP0); gemv8_item(F.in[20], UPN, 1024, 32 * r, 32, coef, red, F.tid, [&](int b, int cl, float s) { o[b * UPN + 32 * r + cl] = s; }); }
        else if (mid == 2) { float* o = WSP(float, WS_BV_NSA); int s0, nv; nsa_colmap(r, s0, nv); gemv8_item(F.in[11], 2608, 1024, s0, nv, coef, red, F.tid, [&](int b, int cl, float s) { o[b * NSAN + 32 * r + cl] = s; }); }
        else { float* o = WSP(float, WS_BV_UP1); gemv8_item(F.in[20] + (size_t)1024 * UPN, UPN, 1024, 32 * r, 32, coef, red, F.tid, [&](int b, int cl, float s) { o[b * UPN + 32 * r + cl] = s; }); }
    }
    { const int gt = F.vcu * NTHR + F.tid; if (gt < 512) { const float* pp = WSP(float, WS_DB) + (((gt >> 8) * 32) << 8) + (gt & 255); float s = 0.f;
#pragma unroll 8
        for (int kc = 0; kc < 32; ++kc) s += pp[kc << 8];
        WSP(float, WS_CMPB)[gt] = s; } }
    const int gw = F.vcu * NWAVES + F.wave, NGW = F.G * NWAVES;
    const float* x = F.in[0]; const float* ng = F.in[4]; bf16* XS = WSP(bf16, WS_XS); float* SSQ = WSP(float, WS_SSQ);
    for (int m = gw; m < MTOK; m += NGW) {
        const int b = m >> 12; float ss = 0.f;
#pragma unroll
        for (int j = 0; j < 4; ++j) { const int col = 4 * F.lane + 256 * j;
            const f32x4 v = *(const f32x4*)(x + (size_t)m * DM + col); const f32x4 g4 = *(const f32x4*)(ng + col), s4 = *(const f32x4*)(MOD + b * 6144 + 1024 + col);
            ss += (v[0] * v[0] + v[1] * v[1]) + (v[2] * v[2] + v[3] * v[3]);
            const f32x4 y = v * (g4 * (1.f + s4)); u32x2 w; w.x = pkbf(y[0], y[1]); w.y = pkbf(y[2], y[3]);
            *(u32x2*)(XS + (size_t)m * DM + col) = w; }
        ss = wave_sum(ss);
        if (F.lane < 16) SSQ[(size_t)m * 16 + F.lane] = F.lane == 0 ? ss : 0.f;
    }
}

__device__ __forceinline__ void hgrn_s1_unit(Frame& F, int u) {
    const int bh = u >> 6, c = u & 63, b = bh >> 2, h = bh & 3; const size_t row0 = (size_t)b * SEQ + 64 * c;
    LAS float* SEGT = (LAS float*)(F.lds); LAS bf16* KT = (LAS bf16*)(F.lds + 2048); LAS bf16* VT = (LAS bf16*)(F.lds + 2048 + 18432);
    const int tid = F.tid, k = tid & 127, seg = tid >> 7;
    float kk[16], bl[16]; float acc = 0.f;
    { const float* lfp = WSP(float, WS_LF) + (row0 + 16 * seg) * HGW + h * 128 + k;
#pragma unroll
      for (int i = 0; i < 16; ++i) { const float v = lfp[(size_t)i * HGW]; kk[i] = 1.f - __expf(v); acc += v; bl[i] = acc; } }
    SEGT[seg * 128 + k] = acc;
    { const bf16* ivp = WSP(bf16, WS_IV) + row0 * HGW + h * 128;
#pragma unroll
      for (int rnd = 0; rnd < 2; ++rnd) { const int idx = tid + NTHR * rnd, s = idx >> 4, ch = idx & 15; const v4u v = *(const v4u*)(ivp + (size_t)s * HGW + 8 * ch);
#pragma unroll
          for (int e = 0; e < 8; ++e) VT[(8 * ch + e) * 72 + s] = (bf16)((e & 1) ? (v[e >> 1] >> 16) : (v[e >> 1] & 0xffffu)); } }
    __syncthreads();
    float pre = 0.f, tot = 0.f;
#pragma unroll
    for (int s2 = 0; s2 < 4; ++s2) { const float x = SEGT[s2 * 128 + k]; tot += x; if (s2 < seg) pre += x; }
    { unsigned pk[8];
#pragma unroll
      for (int i = 0; i < 16; i += 2) pk[i >> 1] = pkbf(kk[i] * __expf(tot - (bl[i] + pre)), kk[i + 1] * __expf(tot - (bl[i + 1] + pre)));
      *(LAS v4u*)(KT + k * 72 + 16 * seg) = (v4u){pk[0], pk[1], pk[2], pk[3]}; *(LAS v4u*)(KT + k * 72 + 16 * seg + 8) = (v4u){pk[4], pk[5], pk[6], pk[7]}; }
    if (seg == 0) WSP(float, WS_DB)[(size_t)u * 128 + k] = __expf(tot);
    __syncthreads();
    const int r = F.lane & 31, hh = F.lane >> 5, ti = F.wave >> 1;
    bf16* up = WSP(bf16, WS_UB) + (size_t)u * 16384;
#pragma unroll
    for (int tt = 0; tt < 2; ++tt) { const int tj = 2 * (F.wave & 1) + tt; f32x16 a16 = {};
#pragma unroll
        for (int ks = 0; ks < 4; ++ks) { const bf16x8 a = *(const LAS bf16x8*)(KT + (32 * ti + r) * 72 + 16 * ks + 8 * hh), bb = *(const LAS bf16x8*)(VT + (32 * tj + r) * 72 + 16 * ks + 8 * hh); a16 = MFMA32(a, bb, a16); }
#pragma unroll
        for (int reg = 0; reg < 16; ++reg) up[(32 * ti + crow(reg, hh)) * 128 + 32 * tj + r] = tobf(a16[reg]); }
    __syncthreads();
}
__device__ __forceinline__ void hgrn_s2(Frame& F) {
    unsigned* UB = WSP(unsigned, WS_UB); const float* DB = WSP(float, WS_DB);
    for (int idx = F.vcu * NTHR + F.tid; idx < 32 * 8192; idx += F.G * NTHR) {
        const int bh = idx >> 13, e = idx & 8191, k = e >> 6, v2 = e & 63;
        unsigned* p = UB + (size_t)bh * 64 * 8192 + k * 64 + v2; const float* dp = DB + (size_t)bh * 64 * 128 + k;
        float s0 = 0.f, s1 = 0.f;
#pragma unroll 8
        for (int c = 0; c < 64; ++c) { const unsigned uu = p[(size_t)c * 8192]; const float dd = dp[c * 128]; p[(size_t)c * 8192] = pkbf(s0, s1); s0 = dd * s0 + bflo(uu); s1 = dd * s1 + bfhi(uu); }
    }
}
__device__ __forceinline__ void hgrn_s3_unit(Frame& F, int u) {
    const int bh = u >> 6, c = u & 63, b = bh >> 2, h = bh & 3; const size_t row0 = (size_t)b * SEQ + 64 * c;
    LAS float* SEGT = (LAS float*)(F.lds); LAS float* SSQP = (LAS float*)(F.lds + 2048);
    LAS bf16* QP = (LAS bf16*)(F.lds + 4096); LAS bf16* KP = (LAS bf16*)(F.lds + 21504); LAS bf16* AM = (LAS bf16*)(F.lds + 38912);
    LAS bf16* VT = (LAS bf16*)(F.lds + 48128); LAS bf16* ST = (LAS bf16*)(F.lds + 66560);
    const int tid = F.tid, k = tid & 127, seg = tid >> 7;
    float kk[16], bl[16], qv[16]; float acc = 0.f;
    { const float* lfp = WSP(float, WS_LF) + (row0 + 16 * seg) * HGW + h * 128 + k; const bf16* qp = WSP(bf16, WS_QH) + (row0 + 16 * seg) * HGW + h * 128 + k;
#pragma unroll
      for (int i = 0; i < 16; ++i) { const float v = lfp[(size_t)i * HGW]; qv[i] = bf2f(qp[(size_t)i * HGW]); kk[i] = 1.f - __expf(v); acc += v; bl[i] = acc; } }
    SEGT[seg * 128 + k] = acc;
    { const bf16* ivp = WSP(bf16, WS_IV) + row0 * HGW + h * 128;
#pragma unroll
      for (int rnd = 0; rnd < 2; ++rnd) { const int idx = tid + NTHR * rnd, s = idx >> 4, ch = idx & 15; const v4u v = *(const v4u*)(ivp + (size_t)s * HGW + 8 * ch);
#pragma unroll
          for (int e = 0; e < 8; ++e) VT[(8 * ch + e) * 72 + s] = (bf16)((e & 1) ? (v[e >> 1] >> 16) : (v[e >> 1] & 0xffffu)); }
      const bf16* sp = WSP(bf16, WS_UB) + (size_t)u * 16384;
#pragma unroll
      for (int rnd = 0; rnd < 4; ++rnd) { const int idx = tid + NTHR * rnd, k2 = idx >> 4, ch = idx & 15; const v4u v = *(const v4u*)(sp + k2 * 128 + 8 * ch);
#pragma unroll
          for (int e = 0; e < 8; ++e) ST[(8 * ch + e) * 136 + k2] = (bf16)((e & 1) ? (v[e >> 1] >> 16) : (v[e >> 1] & 0xffffu)); } }
    __syncthreads();
    float pre = 0.f;
#pragma unroll
    for (int s2 = 0; s2 < 4; ++s2) { const float x = SEGT[s2 * 128 + k]; if (s2 < seg) pre += x; }
#pragma unroll
    for (int i = 0; i < 16; ++i) { const float bi = bl[i] + pre; QP[(16 * seg + i) * 136 + k] = tobf(qv[i] * __expf(bi)); KP[(16 * seg + i) * 136 + k] = tobf(kk[i] * __expf(-bi)); }
    __syncthreads();
    const int r = F.lane & 31, hh = F.lane >> 5, w = F.wave;
    if (w < 3) { const int ti = w ? 1 : 0, tj = w == 2 ? 1 : 0; f32x16 a16 = {};
#pragma unroll
        for (int ks = 0; ks < 8; ++ks) { const bf16x8 a = *(const LAS bf16x8*)(QP + (32 * ti + r) * 136 + 16 * ks + 8 * hh), bb = *(const LAS bf16x8*)(KP + (32 * tj + r) * 136 + 16 * ks + 8 * hh); a16 = MFMA32(a, bb, a16); }
#pragma unroll
        for (int reg = 0; reg < 16; ++reg) { const int t = 32 * ti + crow(reg, hh), s = 32 * tj + r; AM[t * 72 + s] = tobf(s <= t ? a16[reg] : 0.f); }
    } else if (w == 3) {
#pragma unroll
        for (int reg = 0; reg < 16; ++reg) AM[crow(reg, hh) * 72 + 32 + r] = 0;
    }
    __syncthreads();
    const int ti = w >> 2, tj = w & 3; f32x16 o16 = {};
#pragma unroll
    for (int ks = 0; ks < 4; ++ks) { const bf16x8 a = *(const LAS bf16x8*)(AM + (32 * ti + r) * 72 + 16 * ks + 8 * hh), bb = *(const LAS bf16x8*)(VT + (32 * tj + r) * 72 + 16 * ks + 8 * hh); o16 = MFMA32(a, bb, o16); }
#pragma unroll
    for (int ks = 0; ks < 8; ++ks) { const bf16x8 a = *(const LAS bf16x8*)(QP + (32 * ti + r) * 136 + 16 * ks + 8 * hh), bb = *(const LAS bf16x8*)(ST + (32 * tj + r) * 136 + 16 * ks + 8 * hh); o16 = MFMA32(a, bb, o16); }
#pragma unroll
    for (int reg = 0; reg < 16; ++reg) { float x = o16[reg] * o16[reg]; x += __shfl_xor(x, 1); x += __shfl_xor(x, 2); x += __shfl_xor(x, 4); x += __shfl_xor(x, 8); x += __shfl_xor(x, 16);
        if (r == 0) SSQP[(32 * ti + crow(reg, hh)) * 4 + tj] = x; }
    __syncthreads();
    { const int v = 32 * tj + r; const float og = F.in[9][v]; const bf16* gsp = WSP(bf16, WS_GS) + row0 * HGW + h * 128 + v; bf16* aop = WSP(bf16, WS_AO) + row0 * DM + h * 128 + v;
#pragma unroll
      for (int reg = 0; reg < 16; ++reg) { const int t = 32 * ti + crow(reg, hh); const float rs = rsqrtf(((SSQP[t * 4] + SSQP[t * 4 + 1]) + (SSQP[t * 4 + 2] + SSQP[t * 4 + 3])) * (1.f / 128.f) + EPSN);
          aop[(size_t)t * DM] = tobf(o16[reg] * rs * og * bf2f(gsp[(size_t)t * HGW])); } }
    __syncthreads();
}
__device__ __forceinline__ void sconv_pass(Frame& F) {
    const bf16 *GBp = WSP(bf16, WS_GB), *GCp = WSP(bf16, WS_GC), *SVp = WSP(bf16, WS_SV); bf16* AO = WSP(bf16, WS_AO); const float* cw = F.in[10];
    for (int idx = F.vcu * NTHR + F.tid; idx < MTOK * 64; idx += F.G * NTHR) {
        const int row = idx >> 6, col = (idx & 63) * 8, t = row & (SEQ - 1); const size_t o0 = (size_t)row * HGW + col;
        const v4u gb = *(const v4u*)(GBp + o0); v4u c0 = *(const v4u*)(GCp + o0), s0 = *(const v4u*)(SVp + o0), c1 = {}, s1 = {}, c2 = {}, s2 = {};
        if (t >= 1) { c1 = *(const v4u*)(GCp + o0 - HGW); s1 = *(const v4u*)(SVp + o0 - HGW); }
        if (t >= 2) { c2 = *(const v4u*)(GCp + o0 - 2 * HGW); s2 = *(const v4u*)(SVp + o0 - 2 * HGW); }
        float o[8];
#pragma unroll
        for (int e = 0; e < 8; ++e) { const int q = e >> 1; const bool hi = e & 1;
            const float u0 = (hi ? bfhi(c0[q]) : bflo(c0[q])) * (hi ? bfhi(s0[q]) : bflo(s0[q])), u1 = (hi ? bfhi(c1[q]) : bflo(c1[q])) * (hi ? bfhi(s1[q]) : bflo(s1[q])), u2 = (hi ? bfhi(c2[q]) : bflo(c2[q])) * (hi ? bfhi(s2[q]) : bflo(s2[q]));
            o[e] = (hi ? bfhi(gb[q]) : bflo(gb[q])) * (cw[col + e] * u2 + cw[512 + col + e] * u1 + cw[1024 + col + e] * u0); }
        *(v4u*)(AO + (size_t)row * DM + 512 + col) = (v4u){pkbf(o[0], o[1]), pkbf(o[2], o[3]), pkbf(o[4], o[5]), pkbf(o[6], o[7])};
    }
}
__device__ __forceinline__ void convact_pass(Frame& F, const float* cw) {
    const bf16* Gp = WSP(bf16, WS_G); bf16* UPp = WSP(bf16, WS_UP);
    for (size_t idx = (size_t)F.vcu * NTHR + F.tid; idx < (size_t)MTOK * 352; idx += (size_t)F.G * NTHR) {
        const int row = (int)(idx / 352), col = (int)(idx % 352) * 8, t = row & (SEQ - 1); const size_t o0 = (size_t)row * DFF + col;
        const v4u g0 = *(const v4u*)(Gp + o0), up = *(const v4u*)(UPp + o0); v4u g1 = {}, g2 = {};
        if (t >= 1) g1 = *(const v4u*)(Gp + o0 - DFF);
        if (t >= 2) g2 = *(const v4u*)(Gp + o0 - 2 * DFF);
        float o[8];
#pragma unroll
        for (int e = 0; e < 8; ++e) { const int q = e >> 1; const bool hi = e & 1;
            const float a = cw[col + e] * (hi ? bfhi(g2[q]) : bflo(g2[q])) + cw[DFF + col + e] * (hi ? bfhi(g1[q]) : bflo(g1[q])) + cw[2 * DFF + col + e] * (hi ? bfhi(g0[q]) : bflo(g0[q]));
            o[e] = silu_f(a) * (hi ? bfhi(up[q]) : bflo(up[q])); }
        *(v4u*)(UPp + o0) = (v4u){pkbf(o[0], o[1]), pkbf(o[2], o[3]), pkbf(o[4], o[5]), pkbf(o[6], o[7])};
    }
}
__device__ __forceinline__ void cmp2_pass(Frame& F) {
    for (int idx = F.vcu * NTHR + F.tid; idx < 2 * 8192 * 64; idx += F.G * NTHR) {
        const int which = idx >> 19, r = (idx >> 6) & 8191, d = idx & 63; float s = 0.f;
        if ((r & 255) < 255) { const v4u* hp = (const v4u*)(WSP(bf16, WS_HID) + ((size_t)which * 8192 + r) * 256); const float* w2 = F.in[which ? 18 : 16] + d;
#pragma unroll 4
            for (int n8 = 0; n8 < 32; ++n8) { const v4u hv = hp[n8];
#pragma unroll
                for (int q = 0; q < 4; ++q) { s += bflo(hv[q]) * w2[(8 * n8 + 2 * q) * 64]; s += bfhi(hv[q]) * w2[(8 * n8 + 2 * q + 1) * 64]; } } }
        WSP(bf16, which ? WS_VCMP : WS_KCMP)[(size_t)r * 64 + d] = tobf(s);
    }
}
__device__ __forceinline__ void final_pass(Frame& F) {
    const int gw = F.vcu * NWAVES + F.wave, NGW = F.G * NWAVES; const float* fg = F.in[23];
    for (int m = gw; m < MTOK; m += NGW) { f32x4 v[4]; float ss = 0.f;
#pragma unroll
        for (int j = 0; j < 4; ++j) { v[j] = *(const f32x4*)(F.out + (size_t)m * DM + 4 * F.lane + 256 * j); ss += (v[j][0] * v[j][0] + v[j][1] * v[j][1]) + (v[j][2] * v[j][2] + v[j][3] * v[j][3]); }
        const float rs = rsqrtf(wave_sum(ss) * (1.f / DM) + EPSN);
#pragma unroll
        for (int j = 0; j < 4; ++j) *(f32x4*)(F.out + (size_t)m * DM + 4 * F.lane + 256 * j) = v[j] * rs * *(const f32x4*)(fg + 4 * F.lane + 256 * j); }
}

constexpr int AT_LUT = 0, AT_KV = 16384, AT_TILE = 9216, AT_IA = AT_KV + 4 * AT_TILE, AT_IB = AT_IA + 16384, AT_SEL = AT_IB + 16640, AT_WOR = AT_SEL + 512, AT_WSF = AT_WOR + 64, AT_END = AT_WSF + 8 * 32 * 4;
static_assert(AT_END <= RING_BYTES, "attention LDS");
#define AT_KB(buf) (AT_KV + (buf) * 2 * AT_TILE)
#define AT_VB(buf) (AT_KV + (buf) * 2 * AT_TILE + AT_TILE)
typedef short v4i16_t __attribute__((ext_vector_type(4)));
__device__ __forceinline__ void at_scores(f32x16& p, const LAS unsigned char* kt, const bf16x8 (&qr)[4], int c, int h, int sub) {
    p = (f32x16){};
    const LAS unsigned char* kb = kt + (32 * sub + c) * 144 + h * 16;
#pragma unroll
    for (int ks = 0; ks < 4; ++ks) { const bf16x8 a0 = *(const LAS bf16x8*)(kb + ks * 32); p = MFMA32(a0, qr[ks], p); }
}
__device__ __forceinline__ bf16x8 pack8(const f32x16& p, int s) {
    v4u w; w.x = pkbf(p[8 * s], p[8 * s + 1]); w.y = pkbf(p[8 * s + 2], p[8 * s + 3]); w.z = pkbf(p[8 * s + 4], p[8 * s + 5]); w.w = pkbf(p[8 * s + 6], p[8 * s + 7]);
    return __builtin_bit_cast(bf16x8, w);
}
__device__ __forceinline__ void at_pv(const f32x16& p, f32x16 (&o)[2], const LAS unsigned char* vt, int lane, int sub) {
    const int h = lane >> 5, i16 = lane & 15;
    const LAS unsigned char* vb = vt + (32 * sub + 4 * h + (i16 >> 2)) * 144 + (((lane >> 4) & 1) * 16 + (i16 & 3) * 4) * 2;
#pragma unroll
    for (int s = 0; s < 2; ++s) { const bf16x8 A = pack8(p, s);
#pragma unroll
        for (int db = 0; db < 2; ++db) { const LAS unsigned char* bp = vb + (16 * s) * 144 + db * 64;
            const s16x4 lo = __builtin_bit_cast(s16x4, __builtin_amdgcn_ds_read_tr16_b64_v4i16((LAS v4i16_t*)(bp)));
            const s16x4 hi = __builtin_bit_cast(s16x4, __builtin_amdgcn_ds_read_tr16_b64_v4i16((LAS v4i16_t*)(bp + 8 * 144)));
            const bf16x8 B = __builtin_shufflevector(lo, hi, 0, 1, 2, 3, 4, 5, 6, 7); o[db] = MFMA32(A, B, o[db]); } }
}
__device__ __forceinline__ void at_softmax(f32x16& sc, float& m, float& l, f32x16 (&o)[2], LAS float* wsf, int c, int h, bool rescale_o) {
    float mx = fmaxf(sc[0], sc[1]);
#pragma unroll
    for (int r = 2; r < 16; ++r) mx = fmaxf(mx, sc[r]);
    mx = fmaxf(mx, __shfl_xor(mx, 32));
    const float mn = fmaxf(m, mx), alpha = __builtin_amdgcn_exp2f(m - mn);
    const bool grew = mn != m; m = mn;
    float sum = 0.f;
#pragma unroll
    for (int r = 0; r < 16; ++r) { sc[r] = __builtin_amdgcn_exp2f(sc[r] - mn); sum += sc[r]; }
    sum += __shfl_xor(sum, 32); l = l * alpha + sum;
    if (rescale_o && __any(grew)) {
        if (h == 0) wsf[c] = alpha;
        asm volatile("s_waitcnt lgkmcnt(0)" ::: "memory");
#pragma unroll
        for (int r = 0; r < 16; ++r) { const float a = wsf[crow(r, h)]; o[0][r] *= a; o[1][r] *= a; }
    }
}
__device__ __forceinline__ void at_accum(f32x16 (&acc)[2], const f32x16 (&o)[2], float fac, LAS float* wsf, int c, int h) {
    asm volatile("s_waitcnt lgkmcnt(0)" ::: "memory");
    if (h == 0) wsf[c] = fac;
    asm volatile("s_waitcnt lgkmcnt(0)" ::: "memory");
#pragma unroll
    for (int r = 0; r < 16; ++r) { const float a = wsf[crow(r, h)]; acc[0][r] += o[0][r] * a; acc[1][r] += o[1][r] * a; }
}
struct AtState { float m, l; f32x16 o[2]; };
template <int MODE> __device__ __forceinline__ void at_branch(Frame& F, unsigned long long tmask, const bf16* kp, const bf16* vp, int& buf, const bf16x8 (&qr)[4], AtState& st,
                                                              int t, int qb, int q, int i, unsigned long long mysel, float inv_l) {
    LAS unsigned char* lds = F.lds; const LAS float* LUT = (const LAS float*)(lds + AT_LUT);
    int tid = F.tid; asm volatile("" : "+v"(tid));
    const int lane = tid & 63, c = lane & 31, h = lane >> 5;
    LAS float* wsf = (LAS float*)(lds + AT_WSF) + F.wave * 32;
    const int lrow = tid >> 3, lch = tid & 7; const size_t goff = (size_t)lrow * 64 + lch * 8; const int loff = lrow * 144 + lch * 16;
    const float NEG = -INFINITY;
    if (tmask == 0ull) return;
    int s = __builtin_ctzll(tmask);
    v4u kreg = *(const v4u*)(kp + (size_t)s * 4096 + goff), vreg = {};
    if (MODE != 0) vreg = *(const v4u*)(vp + (size_t)s * 4096 + goff);
    for (;;) {
        *(LAS v4u*)(lds + AT_KB(buf) + loff) = kreg; if (MODE != 0) *(LAS v4u*)(lds + AT_VB(buf) + loff) = vreg;
        __syncthreads();
        tmask &= tmask - 1ull; const bool more = tmask != 0ull; const int sn = more ? __builtin_ctzll(tmask) : s;
        if (more) { kreg = *(const v4u*)(kp + (size_t)sn * 4096 + goff); if (MODE != 0) vreg = *(const v4u*)(vp + (size_t)sn * 4096 + goff); }
        const LAS unsigned char* kt = lds + AT_KB(buf); const LAS unsigned char* vt = lds + AT_VB(buf);
        const bool rs = MODE == 2 ? (bool)((mysel >> s) & 1ull) : true;
        if (MODE != 2 || __ballot(rs) != 0ull) {
#pragma unroll
            for (int sub = 0; sub < 2; ++sub) {
                f32x16 p;
                at_scores(p, kt, qr, c, h, sub);
                if (MODE == 0 || MODE == 1) {
                    const int dbase = t - (1024 * s + 512 * sub + 64 * h + 31);
                    if (MODE == 0) {
#pragma unroll
                        for (int r = 0; r < 16; ++r) { const int d0 = dbase - 16 * ((r & 3) + 8 * (r >> 2)); p[r] = d0 >= 0 ? p[r] + LUT[min(d0, 1023) * 4 + i] : NEG; }
                        at_softmax(p, st.m, st.l, st.o, wsf, c, h, false);
                    } else {
#pragma unroll
                        for (int r = 0; r < 16; ++r) { const int d0 = dbase - 16 * ((r & 3) + 8 * (r >> 2)); p[r] = d0 >= 0 ? __builtin_amdgcn_exp2f(p[r] + LUT[min(d0, 1023) * 4 + i] - st.m) * inv_l : 0.f; }
                        LAS float* IA = (LAS float*)(lds + AT_IA); LAS float* IB = (LAS float*)(lds + AT_IB);
#pragma unroll
                        for (int gq = 0; gq < 4; ++gq) {
                            float pb = 0.5f * p[4 * gq + 3], pa = (p[4 * gq] + p[4 * gq + 1]) + (p[4 * gq + 2] + pb);
                            pa += __shfl_xor(pa, 8); pa += __shfl_xor(pa, 16); pb += __shfl_xor(pb, 8); pb += __shfl_xor(pb, 16);
                            const int sb = 16 * s + 8 * sub + 2 * gq + h;
                            if (i == 0) { IA[q * 64 + sb] = pa; IB[q * 65 + sb + 1] = pb; } }
                        at_pv(p, st.o, vt, lane, sub);
                    }
                } else {
                    const int dbase = t - (64 * s + 32 * sub + 4 * h);
                    if (MODE == 2 && qb - s >= 14) {
                        const float bfar = LUT[1023 * 4 + i];
#pragma unroll
                        for (int r = 0; r < 16; ++r) p[r] = rs ? p[r] + bfar : NEG;
                    } else {
#pragma unroll
                        for (int r = 0; r < 16; ++r) { const int d0 = dbase - ((r & 3) + 8 * (r >> 2));
                            const bool ok0 = MODE == 3 ? (d0 >= 0 && d0 < 512) : (rs && d0 >= 0);
                            p[r] = ok0 ? p[r] + LUT[min(max(d0, 0), 1023) * 4 + i] : NEG; }
                    }
                    at_softmax(p, st.m, st.l, st.o, wsf, c, h, true);
                    at_pv(p, st.o, vt, lane, sub);
                }
            }
        }
        buf ^= 1;
        if (!more) break;
        s = sn;
    }
}

__device__ __forceinline__ void attn_unit(Frame& F, int b, int g, int qb, int& buf) {
    LAS unsigned char* lds = F.lds;
    LAS float* IA = (LAS float*)(lds + AT_IA); LAS float* IB = (LAS float*)(lds + AT_IB);
    LAS unsigned* SEL = (LAS unsigned*)(lds + AT_SEL); LAS unsigned* WOR = (LAS unsigned*)(lds + AT_WOR);
    const int tid = F.tid, lane = F.lane, w = F.wave, c = lane & 31, h = lane >> 5, i = c >> 3, q = 8 * w + (c & 7);
    LAS float* wsf = (LAS float*)(lds + AT_WSF) + w * 32;
    const int t0 = 64 * qb, t = t0 + q; const size_t rowbase = (size_t)b * SEQ;
    const bf16* KV6 = WSP(bf16, WS_KV6);
    const bf16* kc = WSP(bf16, WS_KCMP) + (size_t)(b * 4 + g) * 256 * 64; const bf16* vc = WSP(bf16, WS_VCMP) + (size_t)(b * 4 + g) * 256 * 64;
    const bf16* ksp = KV6 + (size_t)((2 * BATCH + b) * 4 + g) * KVPANEL; const bf16* vsp = KV6 + (size_t)((3 * BATCH + b) * 4 + g) * KVPANEL;
    const bf16* kwp = KV6 + (size_t)((4 * BATCH + b) * 4 + g) * KVPANEL; const bf16* vwp = KV6 + (size_t)((5 * BATCH + b) * 4 + g) * KVPANEL;
    bf16x8 qr[4];
    { const bf16* qp = WSP(bf16, WS_QN) + (rowbase + t) * DM + (g * 4 + i) * 64 + 8 * h;
#pragma unroll
      for (int ks = 0; ks < 4; ++ks) qr[ks] = *(const bf16x8*)(qp + 16 * ks); }
    const float* gp = WSP(float, WS_GATES) + (rowbase + t) * 48 + g * 4 + i;
    const float gate_c = gp[0], gate_s = gp[16], gate_w = gp[32];
    __syncthreads();
    for (int x = tid; x < 64 * 64; x += NTHR) IA[x] = 0.f;
    for (int x = tid; x < 64 * 65; x += NTHR) IB[x] = 0.f;
    f32x16 acc[2]; acc[0] = (f32x16){}; acc[1] = (f32x16){};
    AtState st;
    const int ntc = (4 * qb + 3 + 63) >> 6; const unsigned long long cmask = (1ull << ntc) - 1ull;
    st.m = -1e30f; st.l = 0.f; st.o[0] = (f32x16){}; st.o[1] = (f32x16){};
    at_branch<0>(F, cmask, kc, vc, buf, qr, st, t, qb, q, i, 0ull, 0.f);
    at_branch<1>(F, cmask, kc, vc, buf, qr, st, t, qb, q, i, 0ull, st.l > 0.f ? 1.f / st.l : 0.f);
    at_accum(acc, st.o, gate_c, wsf, c, h);
    __syncthreads();
    { const int cur = qb; unsigned long long wor = 0ull;
      for (int qq = 0; qq < 8; ++qq) { const int q2 = 8 * w + qq;
          const bool forced = (lane == 0) || (lane == cur) || (lane == cur - 1);
          const float mine = forced ? INFINITY : IA[q2 * 64 + lane] + IB[q2 * 65 + lane];
          int rank = 0;
          for (int s2 = 0; s2 <= cur; ++s2) { const bool f2 = (s2 == 0) || (s2 == cur) || (s2 == cur - 1); const float ov = f2 ? INFINITY : IA[q2 * 64 + s2] + IB[q2 * 65 + s2];
              rank += (ov > mine || (ov == mine && s2 < lane)) ? 1 : 0; }
          const unsigned long long mask = __ballot(lane <= cur && rank < 16);
          if (lane == 0) { SEL[2 * q2] = (unsigned)mask; SEL[2 * q2 + 1] = (unsigned)(mask >> 32); }
          wor |= mask; }
      if (lane == 0) { WOR[2 * w] = (unsigned)wor; WOR[2 * w + 1] = (unsigned)(wor >> 32); } }
    __syncthreads();
    { unsigned long long uni = 0ull;
#pragma unroll
      for (int x = 0; x < 8; ++x) uni |= (unsigned long long)WOR[2 * x] | ((unsigned long long)WOR[2 * x + 1] << 32);
      const unsigned long long mysel = (unsigned long long)SEL[2 * q] | ((unsigned long long)SEL[2 * q + 1] << 32);
      st.m = -1e30f; st.l = 0.f; st.o[0] = (f32x16){}; st.o[1] = (f32x16){};
      at_branch<2>(F, uni, ksp, vsp, buf, qr, st, t, qb, q, i, mysel, 0.f);
      at_accum(acc, st.o, st.l > 0.f ? gate_s / st.l : 0.f, wsf, c, h);
    }
    { const int lo = max(0, qb - 8); const unsigned long long wmask = ((qb == 63 ? ~0ull : ((1ull << (qb + 1)) - 1ull)) >> lo) << lo;
      st.m = -1e30f; st.l = 0.f; st.o[0] = (f32x16){}; st.o[1] = (f32x16){};
      at_branch<3>(F, wmask, kwp, vwp, buf, qr, st, t, qb, q, i, 0ull, 0.f);
      at_accum(acc, st.o, st.l > 0.f ? gate_w / st.l : 0.f, wsf, c, h);
    }
    { bf16* AO = WSP(bf16, WS_AO);
#pragma unroll
      for (int r = 0; r < 16; ++r) { const int cc = crow(r, h), i2 = cc >> 3, t2 = t0 + 8 * w + (cc & 7); bf16* op = AO + (rowbase + t2) * DM + (g * 4 + i2) * 64 + c;
          op[0] = tobf(acc[0][r]); op[32] = tobf(acc[1][r]); } }
}
__device__ __forceinline__ void attn_phase(Frame& F) {
    LAS float* LUT = (LAS float*)(F.lds + AT_LUT); const int* bucket = WSP(int, WS_BUCKET); const float* rb = F.in[19];
    int curg = -1, buf = 0;
    for (int u = F.vcu; u < 2048; u += F.G) {
        const int v = u & 255, k = u >> 8, g = v >> 6, j = v & 63, a = j >> 3, rp = j & 7;
        const int b = (a + k) & 7, base = 16 * (k >> 1), qb = (k & 1) ? base + 15 - rp : base + rp;
        if (g != curg) { __syncthreads();
            for (int x = F.tid; x < 4096; x += NTHR) LUT[x] = rb[bucket[x >> 2] * 16 + g * 4 + (x & 3)] * LOG2E;
            __syncthreads(); curg = g; }
        attn_unit(F, b, g, qb, buf);
    }
}

constexpr int NPHASE = 19;
struct Args { const float* in[24]; float* out; unsigned char* ws; int ph_lo, ph_hi, li, pad; };
__global__ void __launch_bounds__(NTHR, 2) fwd_kernel(Args args) {
    extern __shared__ __attribute__((aligned(16))) unsigned char lds_raw[];
    Frame F;
    F.lds = (LAS unsigned char*)lds_raw;
    F.tid = threadIdx.x; F.lane = F.tid & 63; F.wave = __builtin_amdgcn_readfirstlane(F.tid >> 6);
    F.G = gridDim.x; { const int bx = blockIdx.x; F.vcu = (F.G % 8 == 0) ? (bx % 8) * (F.G / 8) + bx / 8 : bx; }
    F.in = args.in; F.out = args.out; F.ws = args.ws;
    const int lo = args.ph_lo, hi = args.ph_hi;
    for (int u = F.tid; u < (LDS_BYTES - LDSCTL_OFF) / 4; u += NTHR) ((LAS unsigned*)(F.lds + LDSCTL_OFF))[u] = 0u;
    __syncthreads();
    XcdBarrier bar = xcd_barrier_post((unsigned*)(F.ws + WS_CTL) + CW_BAR, (volatile LAS unsigned*)(F.lds + MISC_OFF) + 8);
#ifndef REP_MASK
#define REP_MASK 0
#endif
#define NREP(k) ((((REP_MASK) >> (k)) & 1) ? 2 : 1)
#ifdef PH_MASK
#define IN(k) ((((PH_MASK) >> (k)) & 1) && lo <= (k) && (k) < hi)
#else
#define IN(k) (lo <= (k) && (k) < hi)
#endif
#define SEAM(k) do { if (IN(k) && IN((k) + 1)) { if ((k) == 0) cg::this_grid().sync(); else xcd_barrier(bar); } asm volatile("" : "+v"(F.tid)); F.lane = F.tid & 63; F.wave = __builtin_amdgcn_readfirstlane(F.tid >> 6); } while (0)
    float* MOD = WSP(float, WS_MOD); float* SSQ = WSP(float, WS_SSQ);
    if (IN(0)) for (int rp_ = 0; rp_ < NREP(0); ++rp_) { p0a(F); } SEAM(0);
    if (IN(1)) for (int rp_ = 0; rp_ < NREP(1); ++rp_) { p0b(F); } SEAM(1);
    if (IN(2)) for (int rp_ = 0; rp_ < NREP(2); ++rp_) {
        pg8::Gemm g{WSP(bf16, WS_XS), WSP(bf16, WS_W_ABIN), MTOK, ABN, 1024, 1024}; pg8::StaticOrder S; S.init(MTOK, ABN, F.G, (int)blockIdx.x);
        EpiAbIn E{SSQ, WSP(float, WS_BV_ABIN), WSP(float, WS_LB), WSP(bf16, WS_QH), WSP(bf16, WS_IV), WSP(bf16, WS_GS), WSP(bf16, WS_GB), WSP(bf16, WS_GC), WSP(bf16, WS_SV), WSP(float, WS_LF)};
        pg8::gemm_phase<EpiAbIn, pg8::StaticOrder, true, true>(F.lds, g, S, E, F.tid);
    } SEAM(2);
    if (IN(3)) for (int rp_ = 0; rp_ < NREP(3); ++rp_) { for (int u = F.vcu; u < 2048; u += F.G) hgrn_s1_unit(F, u); sconv_pass(F); } SEAM(3);
    if (IN(4)) { hgrn_s2(F); } SEAM(4);
    if (IN(5)) for (int rp_ = 0; rp_ < NREP(5); ++rp_) { for (int u = F.vcu; u < 2048; u += F.G) hgrn_s3_unit(F, u); } SEAM(5);
    if (IN(6)) for (int rp_ = 0; rp_ < NREP(6); ++rp_) {
        pg8::Gemm g{WSP(bf16, WS_AO), WSP(bf16, WS_W_ABOUT), MTOK, 1024, 1024, 1024}; pg8::StaticOrder S; S.init(MTOK, 1024, F.G, (int)blockIdx.x);
        EpiRes E{F.in[0], F.out, WSP(bf16, WS_XS), MOD + 2048, F.in[5], MOD + 4096, SSQ, 1};
        pg8::gemm_phase<EpiRes, pg8::StaticOrder, true, true>(F.lds, g, S, E, F.tid);
    } SEAM(6);
    for (int l = 0; l < 2; ++l) {
        const int p = l == 0 ? 7 : 15;
        if (IN(p)) for (int rp_ = 0; rp_ < NREP(7); ++rp_) {
            pg8::Gemm g{WSP(bf16, WS_XS), WSP(bf16, WS_W_UP) + (size_t)l * UPN * 1024, MTOK, UPN, 1024, 1024}; pg8::StaticOrder S; S.init(MTOK, UPN, F.G, (int)blockIdx.x);
            EpiUp E{SSQ, WSP(float, l ? WS_BV_UP1 : WS_BV_UP0), WSP(bf16, WS_G), WSP(bf16, WS_UP)};
            pg8::gemm_phase<EpiUp, pg8::StaticOrder, true, true>(F.lds, g, S, E, F.tid);
        } SEAM(p);
        if (IN(p + 1)) { convact_pass(F, F.in[21] + (size_t)l * 3 * DFF); } SEAM(p + 1);
        if (IN(p + 2)) {
            pg8::Gemm g{WSP(bf16, WS_UP), WSP(bf16, WS_W_DOWN) + (size_t)l * 1024 * DFF, MTOK, 1024, DFF, DFF}; pg8::StaticOrder S; S.init(MTOK, 1024, F.G, (int)blockIdx.x);
            EpiRes E{F.out, F.out, WSP(bf16, WS_XS), MOD + l * 8 * 6144 + 5120, F.in[4] + 1024, MOD + 8 * 6144 + 1024, SSQ, l == 0 ? 1 : 0};
            pg8::gemm_phase<EpiRes, pg8::StaticOrder, true, true>(F.lds, g, S, E, F.tid);
        } SEAM(p + 2);
        if (l == 1) break;
        if (IN(10)) for (int rp_ = 0; rp_ < NREP(10); ++rp_) {
            pg8::Gemm g{WSP(bf16, WS_XS), WSP(bf16, WS_W_NSAIN), MTOK, NSAN, 1024, 1024}; pg8::StaticOrder S; S.init(MTOK, NSAN, F.G, (int)blockIdx.x);
            EpiNsaIn E{SSQ, WSP(float, WS_BV_NSA), WSP(bf16, WS_QN), WSP(bf16, WS_KV6), WSP(float, WS_GATES)};
            pg8::gemm_phase<EpiNsaIn, pg8::StaticOrder, true, true>(F.lds, g, S, E, F.tid);
        } SEAM(10);
        if (IN(11)) for (int rp_ = 0; rp_ < NREP(11); ++rp_) {
#pragma unroll 1
            for (int which = 0; which < 2; ++which) {
                pg8::Gemm g{WSP(bf16, WS_KV6) + (size_t)which * BATCH * 4 * KVPANEL, WSP(bf16, WS_W_CMP1) + (size_t)which * 256 * 2048, 8192, 256, 2048, 1024};
                OffsetOrder S; S.init(8192, 256, F.G, (int)blockIdx.x, which * 32);
                EpiCmp1 E{WSP(float, WS_CMPB) + which * 256, WSP(bf16, WS_HID) + (size_t)which * 8192 * 256};
                pg8::gemm_phase<EpiCmp1, OffsetOrder, true, true>(F.lds, g, S, E, F.tid);
            }
        } SEAM(11);
        if (IN(12)) for (int rp_ = 0; rp_ < NREP(12); ++rp_) { cmp2_pass(F); } SEAM(12);
        if (IN(13)) for (int rp_ = 0; rp_ < NREP(13); ++rp_) { attn_phase(F); } SEAM(13);
        if (IN(14)) {
            pg8::Gemm g{WSP(bf16, WS_AO), WSP(bf16, WS_W_NSAOUT), MTOK, 1024, 1024, 1024}; pg8::StaticOrder S; S.init(MTOK, 1024, F.G, (int)blockIdx.x);
            EpiRes E{F.out, F.out, WSP(bf16, WS_XS), MOD + 8 * 6144 + 2048, F.in[5] + 1024, MOD + 8 * 6144 + 4096, SSQ, 1};
            pg8::gemm_phase<EpiRes, pg8::StaticOrder, true, true>(F.lds, g, S, E, F.tid);
        } SEAM(14);
    }
    if (IN(18)) { final_pass(F); }
#undef IN
#undef SEAM
}

#ifndef MK_SINGLE
#define MK_SINGLE 1
#endif
extern "C" void kernel_launch(void* const* d_in, const int* in_sizes, int n_in, void* d_out, int out_size, void* d_ws, size_t ws_size, hipStream_t stream) {
    static int grid = 0;
    if (grid == 0) {
        if (n_in != 24 || in_sizes[0] != MTOK * DM || out_size != MTOK * DM || ws_size < WS_END) { fprintf(stderr, "kernel_launch: unexpected shapes (n_in %d, in0 %d, out %d, ws %zu)\n", n_in, n_in > 0 ? in_sizes[0] : -1, out_size, ws_size); grid = -1; return; }
        int dev = 0, cus = 0, per_cu = 0;
        if (hipGetDevice(&dev) != hipSuccess || hipDeviceGetAttribute(&cus, hipDeviceAttributeMultiprocessorCount, dev) != hipSuccess) { grid = -1; return; }
        if (hipFuncSetAttribute((const void*)fwd_kernel, hipFuncAttributeMaxDynamicSharedMemorySize, LDS_BYTES) != hipSuccess) { fprintf(stderr, "kernel_launch: hipFuncSetAttribute failed\n"); grid = -1; return; }
        if (hipOccupancyMaxActiveBlocksPerMultiprocessor(&per_cu, (const void*)fwd_kernel, NTHR, LDS_BYTES) != hipSuccess || per_cu < 1) { fprintf(stderr, "kernel_launch: occupancy query gives %d\n", per_cu); per_cu = 1; }
        (void)hipGetLastError();
        grid = cus;
    }
    if (grid < 0) return;
    (void)hipMemsetAsync((char*)d_ws + WS_CTL, 0, CTL_ZERO_BYTES, stream);
    Args a{};
    for (int i = 0; i < 24; ++i) a.in[i] = (const float*)d_in[i];
    a.out = (float*)d_out; a.ws = (unsigned char*)d_ws;
#if MK_SINGLE
    a.ph_lo = 0; a.ph_hi = NPHASE; a.li = 0;
    void* kargs[] = {&a};
    hipError_t e = hipLaunchCooperativeKernel((const void*)fwd_kernel, dim3(grid), dim3(NTHR), kargs, LDS_BYTES, stream);
    if (e != hipSuccess) fprintf(stderr, "kernel_launch: cooperative launch failed: %s (grid %d)\n", hipGetErrorString(e), grid);
#else
    for (int p = 0; p < NPHASE; ++p) { a.ph_lo = p; a.ph_hi = p + 1; a.li = p; hipLaunchKernelGGL(fwd_kernel, dim3(grid), dim3(NTHR), LDS_BYTES, stream, a); }
#endif
}
```

```cpp
#include <hip/hip_runtime.h>
#include <hip/hip_cooperative_groups.h>
#include <cstdio>
#include <cstdint>
namespace cg = cooperative_groups;
namespace pg8 {
#define PG8_LAS __attribute__((address_space(3)))
typedef unsigned short bf16_t;
typedef short bf16x8 __attribute__((ext_vector_type(8)));
typedef float f32x4 __attribute__((ext_vector_type(4)));
typedef unsigned u32x4 __attribute__((ext_vector_type(4)));
constexpr int BM = 256, BK = 64, HALF = 128, HTB = HALF * BK * 2  , STAGE_BYTES = 8 * HTB, NXCD = 8, WGM = 8;

__host__ __device__ __forceinline__ int lds_byte(int r, int c) { const int st = (r >> 4) * 2 + (c >> 5), rr = r & 15, cc = c & 31, ob = rr * 64 + cc * 2; return st * 1024 + (ob ^ (((ob >> 9) & 1) << 5)); }
__host__ __device__ __forceinline__ void stage_rc(int b, int& R, int& C) { const int st = b / 1024, sb = b % 1024, swz = sb ^ (((sb >> 9) & 1) << 5); R = (st >> 1) * 16 + swz / 64; C = (st & 1) * 32 + (swz % 64) / 2; }
__host__ __device__ __forceinline__ int perm32(int rho) { const int n = rho >> 4, i = rho & 15; return 8 * (i >> 2) + 4 * n + (i & 3); }

struct Unit { int pm, pn; };
struct Gemm { const bf16_t* A; const bf16_t* Bt; int M, N, K, lda; };

struct StaticOrder {
    int nM, nN, nwg, G, c;
    __host__ __device__ void init(int M, int N, int G_, int c_) { nM = M / BM; nN = N / BM; nwg = nM * nN; G = G_; c = c_; }
    __host__ __device__ bool next(int i, Unit& u) const {
        const long L = (long)i * G + c; if (L >= nwg) return false;
        int wgid = (int)L; { const int q = nwg / NXCD, r = nwg % NXCD, xcd = wgid % NXCD, off = wgid / NXCD; wgid = (xcd < r ? xcd * (q + 1) : r * (q + 1) + (xcd - r) * q) + off; }
        const int nig = WGM * nN, gid = wgid / nig, fm = gid * WGM, gsz = (nM - fm) < WGM ? (nM - fm) : WGM;
        u.pm = fm + ((wgid % nig) % gsz); u.pn = (wgid % nig) / gsz; return true;
    }
    __device__ __forceinline__ void a_ready(const Unit&) const {}
    __device__ __forceinline__ void done(const Unit&) const {}
};

template <class Epi, class Sched, bool ALIGN_EPI = false, bool SP2 = false>
__device__ __forceinline__ void gemm_phase(PG8_LAS unsigned char* lds, const Gemm g, const Sched& S, const Epi& E, int tid_in) {
    const int tid = tid_in, wid = __builtin_amdgcn_readfirstlane(tid >> 6), lane = tid & 63, wr = wid >> 2, wc = wid & 3, fr = lane & 15, fq = lane >> 4;
    const int K = g.K, nt = K / BK;
    unsigned voffA[2], voffB[2];
#pragma unroll
    for (int i = 0; i < 2; ++i) { int R, C; stage_rc(tid * 16 + i * 8192, R, C); const int Rb = Epi::PERM ? ((R & ~31) + perm32(R & 31)) : R;
        voffA[i] = (unsigned)(R * g.lda + C) * 2u; voffB[i] = (unsigned)(Rb * K + C) * 2u; }
    const size_t kstep = (size_t)(BK * 2);
    const size_t hstepA = (size_t)HALF * g.lda * 2, hstepB = (size_t)HALF * K * 2;
    const size_t tstepA = 2 * hstepA, tstepB = 2 * hstepB;
    const unsigned ldsw = (unsigned)wid * 1024u;
    const int aoff = lds_byte(wr * 64 + fr, fq * 8), boff = lds_byte(wc * 32 + fr, fq * 8);
#define PG8_SA(b, h) (((b) * 2 + (h)) * HTB)
#define PG8_SB(b, h) ((4 + (b) * 2 + (h)) * HTB)
#define PG8_STAGE(bufoff, gbase, voff) do { _Pragma("unroll") for (int _i = 0; _i < 2; ++_i) \
        __builtin_amdgcn_global_load_lds((const unsigned*)((const char*)(gbase) + (voff)[_i]), (PG8_LAS unsigned*)(lds + (bufoff) + ldsw + _i * 8192), 16, 0, 0); } while (0)
#define PG8_LDA(dst, b, h) do { _Pragma("unroll") for (int m = 0; m < 4; ++m) _Pragma("unroll") for (int k = 0; k < 2; ++k) dst[m][k] = *(const PG8_LAS bf16x8*)(lds + PG8_SA(b, h) + aoff + m * 2048 + k * 1024); } while (0)
#define PG8_LDB(dst, b, h) do { _Pragma("unroll") for (int n = 0; n < 2; ++n) _Pragma("unroll") for (int k = 0; k < 2; ++k) dst[n][k] = *(const PG8_LAS bf16x8*)(lds + PG8_SB(b, h) + boff + n * 2048 + k * 1024); } while (0)
#define PG8_MMA(ai, bj, At, Bt) do { __builtin_amdgcn_s_setprio(1); _Pragma("unroll") for (int m = 0; m < 4; ++m) _Pragma("unroll") for (int n = 0; n < 2; ++n) _Pragma("unroll") for (int k = 0; k < 2; ++k) \
        acc[ai][bj][m][n] = __builtin_amdgcn_mfma_f32_16x16x32_bf16(Bt[n][k], At[m][k], acc[ai][bj][m][n], 0, 0, 0); __builtin_amdgcn_s_setprio(0); } while (0)
#define PG8_WAIT_V(n) asm volatile("s_waitcnt vmcnt(" #n ")" ::: "memory")
#define PG8_WAIT_L(n) asm volatile("s_waitcnt lgkmcnt(" #n ")" ::: "memory")
#define PG8_BAR __builtin_amdgcn_s_barrier()
#define PG8_SCHED __builtin_amdgcn_sched_barrier(0)
    Unit cur, nxt; int ui = 0;
    if (!S.next(0, cur)) return;
    f32x4 acc[2][2][4][2];
#pragma unroll
    for (int a = 0; a < 2; ++a)
#pragma unroll
        for (int b = 0; b < 2; ++b)
#pragma unroll
            for (int m = 0; m < 4; ++m)
#pragma unroll
                for (int n = 0; n < 2; ++n) acc[a][b][m][n] = (f32x4){0.f, 0.f, 0.f, 0.f};
    bf16x8 At[4][2], B0[2][2], B1[2][2];
    const char* cA = (const char*)g.A + (size_t)cur.pm * tstepA; const char* cB = (const char*)g.Bt + (size_t)cur.pn * tstepB;
    S.a_ready(cur);
    if constexpr (SP2) {
        PG8_STAGE(PG8_SB(0, 0), cB, voffB); PG8_STAGE(PG8_SB(0, 1), cB + hstepB, voffB); PG8_STAGE(PG8_SA(0, 0), cA, voffA); PG8_STAGE(PG8_SA(0, 1), cA + hstepA, voffA);
        if (wr == 1) PG8_BAR;
        PG8_WAIT_V(2); PG8_BAR;
        PG8_STAGE(PG8_SB(1, 0), cB + kstep, voffB); PG8_STAGE(PG8_SA(1, 0), cA + kstep, voffA); PG8_STAGE(PG8_SB(1, 1), cB + hstepB + kstep, voffB);
        PG8_WAIT_V(6); PG8_BAR;
    } else {
        PG8_STAGE(PG8_SB(0, 0), cB, voffB); PG8_STAGE(PG8_SA(0, 0), cA, voffA); PG8_STAGE(PG8_SB(0, 1), cB + hstepB, voffB); PG8_STAGE(PG8_SA(0, 1), cA + hstepA, voffA);
        if (wr == 1) PG8_BAR;
        PG8_WAIT_V(4); PG8_BAR;
        PG8_STAGE(PG8_SB(1, 0), cB + kstep, voffB); PG8_STAGE(PG8_SA(1, 0), cA + kstep, voffA); PG8_STAGE(PG8_SB(1, 1), cB + hstepB + kstep, voffB);
        PG8_WAIT_V(6); PG8_BAR;
    }
    for (;;) {
        const bool has_next = S.next(ui + 1, nxt);
        const char* nA = has_next ? (const char*)g.A + (size_t)nxt.pm * tstepA : cA; const char* nB = has_next ? (const char*)g.Bt + (size_t)nxt.pn * tstepB : cB;
        for (int t = 0; t < nt; t += 2) {
            const bool last = (t == nt - 2);
            const char* a1 = cA + (size_t)(t + 1) * kstep;
            const char* a2 = last ? nA : cA + (size_t)(t + 2) * kstep; const char* b2 = last ? nB : cB + (size_t)(t + 2) * kstep;
            const char* a3 = a2 + kstep; const char* b3 = b2 + kstep;
            if (last && has_next) S.a_ready(nxt);
            if constexpr (SP2) {
            PG8_LDB(B0, 0, 0); PG8_LDB(B1, 0, 1); PG8_SCHED; PG8_LDA(At, 0, 0); PG8_STAGE(PG8_SA(1, 1), a1 + hstepA, voffA);
            PG8_WAIT_V(8); PG8_WAIT_L(0); PG8_BAR; PG8_MMA(0, 0, At, B0); PG8_MMA(0, 1, At, B1); PG8_BAR; PG8_SCHED;
            PG8_LDA(At, 0, 1); PG8_STAGE(PG8_SB(0, 0), b2, voffB); PG8_STAGE(PG8_SB(0, 1), b2 + hstepB, voffB); PG8_STAGE(PG8_SA(0, 0), a2, voffA);
            PG8_WAIT_V(8); PG8_WAIT_L(0); PG8_BAR; PG8_MMA(1, 0, At, B0); PG8_MMA(1, 1, At, B1); PG8_BAR; PG8_SCHED;
            PG8_LDB(B0, 1, 0); PG8_LDB(B1, 1, 1); PG8_SCHED; PG8_LDA(At, 1, 0); PG8_STAGE(PG8_SA(0, 1), a2 + hstepA, voffA);
            PG8_WAIT_V(8); PG8_WAIT_L(0); PG8_BAR; PG8_MMA(0, 0, At, B0); PG8_MMA(0, 1, At, B1); PG8_BAR; PG8_SCHED;
            PG8_LDA(At, 1, 1); PG8_STAGE(PG8_SB(1, 0), b3, voffB); PG8_STAGE(PG8_SB(1, 1), b3 + hstepB, voffB); PG8_STAGE(PG8_SA(1, 0), a3, voffA);
            PG8_WAIT_V(8); PG8_WAIT_L(0); PG8_BAR; PG8_MMA(1, 0, At, B0); PG8_MMA(1, 1, At, B1); PG8_BAR; PG8_SCHED;
            } else {
            PG8_LDB(B0, 0, 0); PG8_SCHED; PG8_LDA(At, 0, 0); PG8_STAGE(PG8_SA(1, 1), a1 + hstepA, voffA);
            PG8_WAIT_L(8); PG8_BAR; PG8_WAIT_L(0); PG8_MMA(0, 0, At, B0); PG8_BAR; PG8_SCHED;
            PG8_LDB(B1, 0, 1); PG8_STAGE(PG8_SB(0, 0), b2, voffB);
            PG8_BAR; PG8_WAIT_L(0); PG8_MMA(0, 1, At, B1); PG8_BAR;
            PG8_LDA(At, 0, 1); PG8_STAGE(PG8_SA(0, 0), a2, voffA);
            PG8_BAR; PG8_WAIT_L(0); PG8_MMA(1, 0, At, B0); PG8_BAR; PG8_SCHED;
            PG8_STAGE(PG8_SB(0, 1), b2 + hstepB, voffB);
            PG8_WAIT_V(6); PG8_BAR; PG8_MMA(1, 1, At, B1); PG8_BAR;
            PG8_LDB(B0, 1, 0); PG8_SCHED; PG8_LDA(At, 1, 0); PG8_STAGE(PG8_SA(0, 1), a2 + hstepA, voffA);
            PG8_WAIT_L(8); PG8_BAR; PG8_WAIT_L(0); PG8_MMA(0, 0, At, B0); PG8_BAR; PG8_SCHED;
            PG8_LDB(B1, 1, 1); PG8_STAGE(PG8_SB(1, 0), b3, voffB);
            PG8_BAR; PG8_WAIT_L(0); PG8_MMA(0, 1, At, B1); PG8_BAR;
            PG8_LDA(At, 1, 1); PG8_STAGE(PG8_SA(1, 0), a3, voffA);
            PG8_BAR; PG8_WAIT_L(0); PG8_MMA(1, 0, At, B0); PG8_BAR; PG8_SCHED;
            PG8_STAGE(PG8_SB(1, 1), b3 + hstepB, voffB);
            PG8_WAIT_V(6); PG8_BAR; PG8_MMA(1, 1, At, B1); PG8_BAR;
            }
        }
        if constexpr (ALIGN_EPI) { if (wr == 0) PG8_BAR; }
        if constexpr (!Epi::AFTER_DRAIN) { E(acc, cur, wr, wc, fr, fq); S.done(cur); }
        if (!has_next) break;
#pragma unroll
        for (int a = 0; a < 2; ++a)
#pragma unroll
            for (int b = 0; b < 2; ++b)
#pragma unroll
                for (int m = 0; m < 4; ++m)
#pragma unroll
                    for (int n = 0; n < 2; ++n) acc[a][b][m][n] = (f32x4){0.f, 0.f, 0.f, 0.f};
        cur = nxt; cA = nA; cB = nB; ++ui;
        if constexpr (ALIGN_EPI) { if (wr == 1) PG8_BAR; }
    }
    PG8_WAIT_V(0);
    if constexpr (!ALIGN_EPI) { if (wr == 0) PG8_BAR; }
    PG8_BAR;
    if constexpr (Epi::AFTER_DRAIN) { E.fused(acc, cur, wr, wc, fr, fq, lds, wid, lane); S.done(cur); }
#undef PG8_SA
#undef PG8_SB
#undef PG8_STAGE
#undef PG8_LDA
#undef PG8_LDB
#undef PG8_MMA
#undef PG8_WAIT_V
#undef PG8_WAIT_L
#undef PG8_BAR
#undef PG8_SCHED
}
}
#define GAS __attribute__((address_space(1)))
#define LAS __attribute__((address_space(3)))
typedef unsigned short bf16;
typedef unsigned v4u __attribute__((ext_vector_type(4)));
typedef float f32x4 __attribute__((ext_vector_type(4)));
typedef short bf16x8 __attribute__((ext_vector_type(8)));
typedef GAS unsigned gu32;
typedef GAS unsigned long long gu64;
#define RLX_AGENT __ATOMIC_RELAXED, __HIP_MEMORY_SCOPE_AGENT
#define LDS_WAIT() asm volatile("s_waitcnt lgkmcnt(0)" ::: "memory")
#define VM_WAIT() asm volatile("s_waitcnt vmcnt(0)" ::: "memory")
__device__ __forceinline__ unsigned long long rt() { return __builtin_amdgcn_s_memrealtime(); }
__device__ __forceinline__ unsigned f2bf(float f) { unsigned u = __builtin_bit_cast(unsigned, f); return (u + 0x7fffu + ((u >> 16) & 1u)) >> 16; }
__device__ __forceinline__ unsigned pk2(float lo, float hi) { return f2bf(lo) | (f2bf(hi) << 16); }

#define XB_TMO      128
#define XB_XCNT(j)  (256  + 64 * (j))
#define XB_XSUB(j)  (1280 + 64 * (j))
#define XB_XGEN(j)  (2304 + 64 * (j))
#define XB_TOP      3328
#define XB_TOPGEN   3392
#define XCD_BAR_WORDS 3456
#define XB_SPIN_CAP (1u << 18)

__device__ __forceinline__ unsigned xb_ld(unsigned* p)              { return __hip_atomic_load(p, __ATOMIC_RELAXED, __HIP_MEMORY_SCOPE_AGENT); }
__device__ __forceinline__ unsigned xb_add(unsigned* p, unsigned v) { return __hip_atomic_fetch_add(p, v, __ATOMIC_RELAXED, __HIP_MEMORY_SCOPE_AGENT); }
__device__ __forceinline__ unsigned xb_xcc_id() { return (unsigned)__builtin_amdgcn_s_getreg((3 << 11) | 20) & 0xFu; }
#define XB_SPIN(cond, bar) do { unsigned _sp = 0; while (cond) { __builtin_amdgcn_s_sleep(1); \
    if ((++_sp & 255u) == 0u) { if (xb_ld(&(bar)[XB_TMO])) break; if (_sp > XB_SPIN_CAP) { atomicAdd(&(bar)[XB_TMO], 1u); break; } } } } while (0)

struct XcdBarrier {
    unsigned* bar; unsigned x;
    volatile LAS unsigned* st;
};

__device__ __forceinline__ XcdBarrier xcd_barrier_post(unsigned* bar, volatile LAS unsigned* st) {
    XcdBarrier b; b.bar = bar; b.x = xb_xcc_id(); b.st = st;
    if (threadIdx.x == 0) (void)xb_add(&bar[XB_XCNT(b.x)], 1u);
    return b;
}
__device__ __forceinline__ void xcd_barrier_complete(unsigned* bar, unsigned x, unsigned& nloc, unsigned& nx) {
    const unsigned G = gridDim.x * gridDim.y * gridDim.z;
    unsigned sum, cnt, mine, sp = 0u;
    for (;;) {
        sum = 0u; cnt = 0u; mine = 0u;
#pragma unroll
        for (unsigned j = 0; j < 16; ++j) { const unsigned c = xb_ld(&bar[XB_XCNT(j)]); sum += c; cnt += (c > 0u) ? 1u : 0u; mine = (j == x) ? c : mine; }
        if (sum == G) break;
        __builtin_amdgcn_s_sleep(1);
        if ((++sp & 255u) == 0u) { if (xb_ld(&bar[XB_TMO])) break; if (sp > XB_SPIN_CAP) { atomicAdd(&bar[XB_TMO], 1u); break; } }
    }
    nloc = mine > 0u ? mine : 1u; nx = cnt > 0u ? cnt : 1u;
}

__device__ __forceinline__ void xcd_barrier(const XcdBarrier& b) {
    asm volatile("s_waitcnt vmcnt(0)" ::: "memory");
    __syncthreads();
    if (threadIdx.x == 0) {
        unsigned* bar = b.bar;
        __builtin_amdgcn_s_waitcnt(0);
        unsigned nloc = b.st[0], nx = b.st[1];
        if (nloc == 0u) { xcd_barrier_complete(bar, b.x, nloc, nx); b.st[0] = nloc; b.st[1] = nx; }
        const unsigned old = xb_add(&bar[XB_XSUB(b.x)], 1u);
        const unsigned gen = old / nloc;
        if (old + 1u == (gen + 1u) * nloc) {
            __builtin_amdgcn_fence(__ATOMIC_RELEASE, "agent");
            asm volatile("s_waitcnt vmcnt(0)" ::: "memory");
            const unsigned og = xb_add(&bar[XB_TOP], 1u);
            const unsigned tg = og / nx;
            if (og + 1u == (tg + 1u) * nx) xb_add(&bar[XB_TOPGEN], 1u);
            else XB_SPIN(xb_ld(&bar[XB_TOPGEN]) == tg, bar);
            __builtin_amdgcn_fence(__ATOMIC_ACQUIRE, "agent");
            xb_add(&bar[XB_XGEN(b.x)], 1u);
            asm volatile("s_waitcnt vmcnt(0)" ::: "memory");
        } else {
            XB_SPIN(xb_ld(&bar[XB_XGEN(b.x)]) == gen, bar);
            __builtin_amdgcn_fence(__ATOMIC_ACQUIRE, "agent");
            asm volatile("s_waitcnt vmcnt(0)" ::: "memory");
        }
    }
    __syncthreads();
}

constexpr int NWAVES = 8, NTHR = 512;
constexpr int BATCH = 8, SEQ = 4096, DM = 1024, MTOK = BATCH * SEQ;
constexpr int HGW = 512, ABN = 3584, DFF = 2816, UPN = 5632, NSAN = 2816;
constexpr float EPSN = 1e-6f;
constexpr float LOG2E = 1.4426950408889634f;
constexpr float QSCALE = 0.125f * LOG2E;

constexpr size_t MiB = (size_t)1 << 20;
constexpr size_t WS_CTL = 0, CTL_ZERO_BYTES = 1 * MiB;
constexpr size_t WS_MOD = 1 * MiB;
constexpr size_t WS_BV_ABIN = WS_MOD + 393216;
constexpr size_t WS_BV_UP0 = WS_BV_ABIN + 114688;
constexpr size_t WS_BV_NSA = WS_BV_UP0 + 180224;
constexpr size_t WS_BV_UP1 = WS_BV_NSA + 90112;
constexpr size_t WS_LB = WS_BV_UP1 + 180224;
constexpr size_t WS_BUCKET = WS_LB + 2048;
constexpr size_t WS_CMPB = WS_BUCKET + 16384;
static_assert(WS_CMPB + 2048 <= 2 * MiB, "tables");
constexpr size_t WS_SSQ = 3 * MiB;
constexpr size_t WS_DB = 5 * MiB;
constexpr size_t WS_GATES = 6 * MiB;
constexpr size_t WS_W_ABIN = 12 * MiB, WS_W_ABOUT = 19 * MiB, WS_W_NSAIN = 21 * MiB, WS_W_NSAOUT = 27 * MiB;
constexpr size_t WS_W_UP = 29 * MiB, WS_W_DOWN = 51 * MiB, WS_W_CMP1 = 62 * MiB;
constexpr size_t WS_XS = 64 * MiB;
constexpr size_t WS_AO = 128 * MiB;
constexpr size_t WS_QH = 192 * MiB, WS_IV = 224 * MiB, WS_GS = 256 * MiB, WS_GB = 288 * MiB, WS_GC = 320 * MiB, WS_SV = 352 * MiB;
constexpr size_t WS_LF = 384 * MiB;
constexpr size_t WS_UB = 448 * MiB;
constexpr size_t WS_SIDE = 200 * MiB, WS_UP = 304 * MiB;
constexpr size_t WS_QN = 192 * MiB;
constexpr size_t WS_KV6 = 256 * MiB;
constexpr size_t WS_HID = 352 * MiB;
constexpr size_t WS_KCMP = 360 * MiB, WS_VCMP = 361 * MiB;
constexpr size_t WS_END = 512 * MiB;
constexpr size_t KVPANEL = (size_t)SEQ * 64;

constexpr int RING_BYTES = 131072;
constexpr int LDS_BYTES = 147456;
constexpr int LDSCTL_OFF = RING_BYTES, MISC_OFF = LDSCTL_OFF + 320;
constexpr int CW_BAR = 4096;

__device__ __forceinline__ unsigned pkbf(float lo, float hi) {
    typedef float f2_t __attribute__((ext_vector_type(2))); typedef __bf16 b2_t __attribute__((ext_vector_type(2)));
    f2_t v = {lo, hi}; b2_t b = __builtin_convertvector(v, b2_t); return __builtin_bit_cast(unsigned, b);
}
__device__ __forceinline__ unsigned short tobf(float f) { return (unsigned short)(pkbf(f, 0.f) & 0xffffu); }
__device__ __forceinline__ float bflo(unsigned u) { return __uint_as_float(u << 16); }
__device__ __forceinline__ float bfhi(unsigned u) { return __uint_as_float(u & 0xffff0000u); }
__device__ __forceinline__ float bf2f(unsigned short u) { return __uint_as_float((unsigned)u << 16); }
__device__ __forceinline__ float sigmoid_f(float v) { return 1.f / (1.f + __expf(-v)); }
__device__ __forceinline__ float silu_f(float v) { return v / (1.f + __expf(-v)); }
__device__ __forceinline__ int crow(int reg, int h) { return (reg & 3) + 8 * (reg >> 2) + 4 * h; }
typedef float f32x16 __attribute__((ext_vector_type(16)));
typedef short s16x4 __attribute__((ext_vector_type(4)));
typedef unsigned u32x2 __attribute__((ext_vector_type(2)));
#define MFMA32(a, b, c) __builtin_amdgcn_mfma_f32_32x32x16_bf16((a), (b), (c), 0, 0, 0)
__device__ __forceinline__ float wave_sum(float v) {
#pragma unroll
    for (int o = 1; o < 64; o <<= 1) v += __shfl_xor(v, o);
    return v;
}

struct Frame {
    LAS unsigned char* lds;
    int tid, lane, wave, vcu, G;
    const float* const* in;
    float* out; unsigned char* ws;
};
#define WSP(T, off) ((T*)(F.ws + (off)))

__device__ __forceinline__ float row_rstd(const float* ssq, int row) {
    const f32x4* p = (const f32x4*)(ssq + (size_t)row * 16);
    const f32x4 a = p[0], b = p[1], c = p[2], d = p[3];
    const float s = ((a.x + a.y) + (a.z + a.w)) + ((b.x + b.y) + (b.z + b.w)) + ((c.x + c.y) + (c.z + c.w)) + ((d.x + d.y) + (d.z + d.w));
    return rsqrtf(s * (1.0f / DM) + EPSN);
}

constexpr int XCH_OFF = RING_BYTES + 1024;
constexpr int RSTD_OFF = RING_BYTES + 5120;
struct StaticOrderRs : pg8::StaticOrder {
    const float* ssq; LAS float* tab; int tid; mutable int cnt;
    __device__ __forceinline__ void a_ready(const pg8::Unit& u) const { const int slot = cnt & 1; ++cnt; if (tid < 256) tab[slot * 256 + tid] = row_rstd(ssq, u.pm * 256 + tid); }
};
#define EPI_LOOP_ROWS _Pragma("unroll") for (int ai = 0; ai < 2; ++ai) _Pragma("unroll") for (int m = 0; m < 4; ++m)
#define EPI_LOOP_BJ _Pragma("unroll") for (int bj = 0; bj < 2; ++bj)
__device__ __forceinline__ v4u pack8f(const f32x4& a, const f32x4& b) { return (v4u){pkbf(a[0], a[1]), pkbf(a[2], a[3]), pkbf(b[0], b[1]), pkbf(b[2], b[3])}; }

struct EpiAbIn {
    static constexpr bool PERM = true, AFTER_DRAIN = false;
    const LAS float* rtab; const float* bv; const float* lb; bf16 *QH, *IV, *GS, *GB, *GC, *SV; float* LF; mutable int ecnt;
    template <int SEG> __device__ __forceinline__ void emit(const f32x4 (&acc)[2][2][4][2], const pg8::Unit& u, int wr, int wc, int fr, int fq, const LAS float* rt) const {
        asm volatile("" : "+v"(fr), "+v"(fq));
        const int cs0 = (u.pn & 1) * 256; const int b = (u.pm * 256) >> 12;
        EPI_LOOP_ROWS {
            const int row = u.pm * 256 + ai * 128 + wr * 64 + m * 16 + fr; const float rs = rt[ai * 128 + wr * 64 + m * 16 + fr];
            EPI_LOOP_BJ {
                const int cl = bj * 128 + wc * 32 + fq * 8, cs = cs0 + cl, cn = u.pn * 256 + cl;
                f32x4 v0 = acc[ai][bj][m][0] * rs + *(const f32x4*)(bv + b * ABN + cn), v1 = acc[ai][bj][m][1] * rs + *(const f32x4*)(bv + b * ABN + cn + 4);
                if (SEG == 1) {
                    const f32x4 l0 = *(const f32x4*)(lb + cs), l1 = *(const f32x4*)(lb + cs + 4); f32x4 o0, o1;
#pragma unroll
                    for (int e = 0; e < 4; ++e) { o0[e] = __logf(l0[e] + (1.f - l0[e]) * sigmoid_f(v0[e])); o1[e] = __logf(l1[e] + (1.f - l1[e]) * sigmoid_f(v1[e])); }
                    *(f32x4*)(LF + (size_t)row * HGW + cs) = o0; *(f32x4*)(LF + (size_t)row * HGW + cs + 4) = o1;
                } else {
                    if (SEG == 3) {
#pragma unroll
                        for (int e = 0; e < 4; ++e) { v0[e] = silu_f(v0[e]); v1[e] = silu_f(v1[e]); }
                    }
                    bf16* dst = SEG == 0 ? QH : SEG == 2 ? IV : SEG == 3 ? GS : SEG == 4 ? GB : SEG == 5 ? GC : SV;
                    *(v4u*)(dst + (size_t)row * HGW + cs) = pack8f(v0, v1);
                }
            }
        }
    }
    __device__ __forceinline__ void operator()(const f32x4 (&acc)[2][2][4][2], const pg8::Unit& u, int wr, int wc, int fr, int fq) const {
        asm volatile("" : "+v"(fr), "+v"(fq));
        const LAS float* rt = rtab + (ecnt & 1) * 256; ++ecnt;
        switch (u.pn >> 1) {
            case 0: emit<0>(acc, u, wr, wc, fr, fq, rt); break; case 1: emit<1>(acc, u, wr, wc, fr, fq, rt); break; case 2: emit<2>(acc, u, wr, wc, fr, fq, rt); break;
            case 3: emit<3>(acc, u, wr, wc, fr, fq, rt); break; case 4: emit<4>(acc, u, wr, wc, fr, fq, rt); break; case 5: emit<5>(acc, u, wr, wc, fr, fq, rt); break;
            default: emit<6>(acc, u, wr, wc, fr, fq, rt); break;
        }
    }
};

struct EpiRes {
    static constexpr bool PERM = true, AFTER_DRAIN = false;
    const float* xin; float* xout; bf16* xs; const float* gate; const float* ng; const float* nsc; float* ssq; int has_next;
    __device__ __forceinline__ void operator()(const f32x4 (&acc)[2][2][4][2], const pg8::Unit& u, int wr, int wc, int fr, int fq) const {
        asm volatile("" : "+v"(fr), "+v"(fq));
        const int b = (u.pm * 256) >> 12;
        EPI_LOOP_ROWS {
            const int row = u.pm * 256 + ai * 128 + wr * 64 + m * 16 + fr; float ss = 0.f;
            EPI_LOOP_BJ {
                const int cn = u.pn * 256 + bj * 128 + wc * 32 + fq * 8; const size_t off = (size_t)row * DM + cn;
                const f32x4 x0 = *(const f32x4*)(xin + off) + *(const f32x4*)(gate + b * 6144 + cn) * acc[ai][bj][m][0];
                const f32x4 x1 = *(const f32x4*)(xin + off + 4) + *(const f32x4*)(gate + b * 6144 + cn + 4) * acc[ai][bj][m][1];
                *(f32x4*)(xout + off) = x0; *(f32x4*)(xout + off + 4) = x1;
                ss += ((x0[0] * x0[0] + x0[1] * x0[1]) + (x0[2] * x0[2] + x0[3] * x0[3])) + ((x1[0] * x1[0] + x1[1] * x1[1]) + (x1[2] * x1[2] + x1[3] * x1[3]));
                if (has_next) {
                    const f32x4 y0 = x0 * (*(const f32x4*)(ng + cn) * (1.f + *(const f32x4*)(nsc + b * 6144 + cn)));
                    const f32x4 y1 = x1 * (*(const f32x4*)(ng + cn + 4) * (1.f + *(const f32x4*)(nsc + b * 6144 + cn + 4)));
                    *(v4u*)(xs + off) = pack8f(y0, y1);
                }
            }
            ss += __shfl_xor(ss, 16); ss += __shfl_xor(ss, 32);
            if (fq == 0) ssq[(size_t)row * 16 + u.pn * 4 + wc] = ss;
        }
    }
};

__device__ __forceinline__ float dpp_ror1(float v) { return __builtin_bit_cast(float, __builtin_amdgcn_update_dpp(0, __builtin_bit_cast(int, v), 0x121, 0xf, 0xf, false)); }
__device__ __forceinline__ float dpp_ror2(float v) { return __builtin_bit_cast(float, __builtin_amdgcn_update_dpp(0, __builtin_bit_cast(int, v), 0x122, 0xf, 0xf, false)); }
__device__ __forceinline__ float dpp_shr1(float old, float v) { return __builtin_bit_cast(float, __builtin_amdgcn_update_dpp(__builtin_bit_cast(int, old), __builtin_bit_cast(int, v), 0x111, 0xf, 0xf, false)); }
__device__ __forceinline__ float dpp_shr2(float old, float v) { return __builtin_bit_cast(float, __builtin_amdgcn_update_dpp(__builtin_bit_cast(int, old), __builtin_bit_cast(int, v), 0x112, 0xf, 0xf, false)); }
struct EpiUpConv {
    static constexpr bool PERM = true, AFTER_DRAIN = false;
    const LAS float* rtab; const float* bv; const float* cw; bf16* H; float* SIDE; LAS float* xch; int wid; mutable int ecnt;
    __device__ __forceinline__ void operator()(const f32x4 (&acc)[2][2][4][2], const pg8::Unit& u, int wr, int wc, int fr, int fq) const {
        asm volatile("" : "+v"(fr), "+v"(fq));
        const int b = (u.pm * 256) >> 12, ff0 = u.pn * 128 + wc * 32 + fq * 8;
        const LAS float* rt = rtab + (ecnt & 1) * 256 + wr * 64 + fr; ++ecnt;
        {
            float* side = SIDE + (size_t)u.pm * 6 * DFF + ff0;
#pragma unroll
            for (int n = 0; n < 2; ++n) {
                const f32x4 bg = *(const f32x4*)(bv + b * UPN + ff0 + 4 * n);
                if (fr >= 14) {
#pragma unroll
                    for (int ai = 0; ai < 2; ++ai) *(LAS f32x4*)(xch + ((wid * 2 + ai) * 2 + (fr - 14)) * 32 + fq * 8 + 4 * n) = acc[ai][0][3][n] * rt[ai * 128 + 48] + bg;
                    if (wr == 1) *(f32x4*)(side + (size_t)(fr - 14) * DFF + 4 * n) = acc[1][0][3][n] * rt[128 + 48] + bg;
                }
                if (wr == 0 && fr < 2) {
                    const f32x4 bu = *(const f32x4*)(bv + b * UPN + DFF + ff0 + 4 * n);
                    *(f32x4*)(side + (size_t)(2 + fr) * DFF + 4 * n) = acc[0][0][0][n] * rt[0] + bg; *(f32x4*)(side + (size_t)(4 + fr) * DFF + 4 * n) = acc[0][1][0][n] * rt[0] + bu;
                }
            }
        }
        asm volatile("s_waitcnt lgkmcnt(0)" ::: "memory"); __builtin_amdgcn_s_barrier(); asm volatile("" ::: "memory");
#pragma unroll
        for (int n = 0; n < 2; ++n) {
            const int fc = ff0 + 4 * n;
            const f32x4 bg = *(const f32x4*)(bv + b * UPN + fc), bu = *(const f32x4*)(bv + b * UPN + DFF + fc);
            const f32x4 w0 = *(const f32x4*)(cw + fc), w1 = *(const f32x4*)(cw + DFF + fc), w2 = *(const f32x4*)(cw + 2 * DFF + fc);
#pragma unroll
            for (int ai = 0; ai < 2; ++ai) {
                f32x4 prev = {0.f, 0.f, 0.f, 0.f};
                if (!(ai == 0 && wr == 0)) {
                    const int srcw = (ai == 0) ? (wid & 3) : (wr == 0 ? 4 + (wid & 3) : (wid & 3)), sai = (ai == 1 && wr == 1) ? 1 : 0;
                    prev = *(const LAS f32x4*)(xch + ((srcw * 2 + sai) * 2 + (fr == 14 ? 0 : 1)) * 32 + fq * 8 + 4 * n);
                }
#pragma unroll
                for (int m = 0; m < 4; ++m) {
                    const int row = u.pm * 256 + ai * 128 + wr * 64 + m * 16 + fr;
                    const float rsv = rt[ai * 128 + m * 16]; const f32x4 g0 = acc[ai][0][m][n] * rsv + bg, up = acc[ai][1][m][n] * rsv + bu; f32x4 hv;
#pragma unroll
                    for (int e = 0; e < 4; ++e) { const float g1 = dpp_shr1(dpp_ror1(prev[e]), g0[e]), g2 = dpp_shr2(dpp_ror2(prev[e]), g0[e]); hv[e] = silu_f(w0[e] * g2 + w1[e] * g1 + w2[e] * g0[e]) * up[e]; }
                    prev = g0;
                    *(u32x2*)(H + (size_t)row * DFF + fc) = (u32x2){pkbf(hv[0], hv[1]), pkbf(hv[2], hv[3])};
                    asm volatile("" ::: "memory");
                }
            }
        }
    }
};

struct EpiNsaIn {
    static constexpr bool PERM = true, AFTER_DRAIN = false;
    const LAS float* rtab; const float* bv; bf16* QN; bf16* KV6; float* GATES; mutable int ecnt;
    __device__ __forceinline__ void operator()(const f32x4 (&acc)[2][2][4][2], const pg8::Unit& u, int wr, int wc, int fr, int fq) const {
        asm volatile("" : "+v"(fr), "+v"(fq));
        const int b = (u.pm * 256) >> 12; const LAS float* rt = rtab + (ecnt & 1) * 256; ++ecnt;
        EPI_LOOP_ROWS {
            const int row = u.pm * 256 + ai * 128 + wr * 64 + m * 16 + fr; const int t = row & (SEQ - 1); const float rs = rt[ai * 128 + wr * 64 + m * 16 + fr];
            EPI_LOOP_BJ {
                const int cl = bj * 128 + wc * 32 + fq * 8;
                f32x4 v0 = acc[ai][bj][m][0] * rs + *(const f32x4*)(bv + b * NSAN + u.pn * 256 + cl), v1 = acc[ai][bj][m][1] * rs + *(const f32x4*)(bv + b * NSAN + u.pn * 256 + cl + 4);
                if (u.pn < 4) {
                    *(v4u*)(QN + (size_t)row * DM + u.pn * 256 + cl) = pack8f(v0 * QSCALE, v1 * QSCALE);
                } else if (u.pn < 10) {
                    const int idx = u.pn - 4, g = cl >> 6, d = cl & 63;
                    *(v4u*)(KV6 + ((size_t)((idx * BATCH + b) * 4 + g)) * KVPANEL + (size_t)t * 64 + d) = pack8f(v0, v1);
                } else if (cl < 48) {
#pragma unroll
                    for (int e = 0; e < 4; ++e) { v0[e] = sigmoid_f(v0[e]); v1[e] = sigmoid_f(v1[e]); }
                    *(f32x4*)(GATES + (size_t)row * 48 + cl) = v0; *(f32x4*)(GATES + (size_t)row * 48 + cl + 4) = v1;
                }
            }
        }
    }
};

struct EpiCmp1 {
    static constexpr bool PERM = true, AFTER_DRAIN = false;
    const float* cb; bf16* HID;
    __device__ __forceinline__ void operator()(const f32x4 (&acc)[2][2][4][2], const pg8::Unit& u, int wr, int wc, int fr, int fq) const {
        asm volatile("" : "+v"(fr), "+v"(fq));
        EPI_LOOP_ROWS {
            const int row = u.pm * 256 + ai * 128 + wr * 64 + m * 16 + fr;
            EPI_LOOP_BJ {
                const int cl = bj * 128 + wc * 32 + fq * 8;
                f32x4 v0 = acc[ai][bj][m][0] + *(const f32x4*)(cb + cl), v1 = acc[ai][bj][m][1] + *(const f32x4*)(cb + cl + 4);
#pragma unroll
                for (int e = 0; e < 4; ++e) { v0[e] = silu_f(v0[e]); v1[e] = silu_f(v1[e]); }
                *(v4u*)(HID + (size_t)row * 256 + cl) = pack8f(v0, v1);
            }
        }
    }
};
struct OffsetOrder {
    int nM, nN, nwg, G, c;
    __device__ void init(int M_, int N_, int G_, int c_, int off) { nM = M_ / 256; nN = N_ / 256; nwg = nM * nN; G = G_; c = (c_ - off + 4 * G_) % G_; }
    __device__ bool next(int i, pg8::Unit& u) const { const long L = (long)i * G + c; if (L >= nwg) return false; u.pm = (int)L / nN; u.pn = (int)L % nN; return true; }
    __device__ __forceinline__ void a_ready(const pg8::Unit&) const {}
    __device__ __forceinline__ void done(const pg8::Unit&) const {}
};

__device__ __forceinline__ void transpose_item(const float* W, int K, int N, bf16* WT, int k0, int dst_row0, int src_col0, int nvalid, LAS float* scr, int lane) {
    const int j = lane & 31; const bool ok = j < nvalid;
#pragma unroll 8
    for (int i = 0; i < 32; ++i) { const int kk = 2 * i + (lane >> 5); scr[kk * 33 + j] = ok ? W[(size_t)(k0 + kk) * N + src_col0 + j] : 0.f; }
    LDS_WAIT(); asm volatile("" ::: "memory");
    const int c = lane & 7;
#pragma unroll
    for (int j4 = 0; j4 < 4; ++j4) { const int n = (lane >> 3) + 8 * j4; const LAS float* s = scr + (8 * c) * 33 + n;
        v4u o; o.x = pkbf(s[0 * 33], s[1 * 33]); o.y = pkbf(s[2 * 33], s[3 * 33]); o.z = pkbf(s[4 * 33], s[5 * 33]); o.w = pkbf(s[6 * 33], s[7 * 33]);
        *(v4u*)(WT + (size_t)(dst_row0 + n) * K + k0 + 8 * c) = o; }
    LDS_WAIT(); asm volatile("" ::: "memory");
}
__device__ __forceinline__ void nsa_colmap(int nb, int& src0, int& nv) {
    if (nb < 32) { src0 = 32 * nb; nv = 32; }
    else if (nb < 80) { src0 = 32 * nb + 48; nv = 32; }
    else if (nb == 80) { src0 = 1024; nv = 32; }
    else if (nb == 81) { src0 = 1056; nv = 16; }
    else { src0 = 0; nv = 0; }
}
template <class OutF> __device__ __forceinline__ void gemv8_item(const float* W, int ldw, int K, int src_col0, int nvalid, const LAS float* coef, LAS float* red, int tid, OutF out) {
    const int cl = tid & 31, kg = tid >> 5;
    float acc[8];
#pragma unroll
    for (int b = 0; b < 8; ++b) acc[b] = 0.f;
    const bool valid = cl < nvalid;
    const float* wp = W + (size_t)kg * ldw + src_col0 + cl;
#pragma unroll 8
    for (int kk = 0; kk < K / 16; ++kk) { const float w = valid ? wp[(size_t)kk * 16 * ldw] : 0.f; const int k = kg + 16 * kk;
#pragma unroll
        for (int b = 0; b < 8; ++b) acc[b] += coef[b * K + k] * w; }
#pragma unroll
    for (int b = 0; b < 8; ++b) red[(kg * 8 + b) * 32 + cl] = acc[b];
    __syncthreads();
    if (tid < 256) { const int b = tid >> 5; float s = 0.f;
#pragma unroll
        for (int k2 = 0; k2 < 16; ++k2) s += red[(k2 * 8 + b) * 32 + cl];
        out(b, cl, s); }
    __syncthreads();
}
constexpr int P0_TSCR = 0, P0_COEF = 69632, P0_RED = 102400;

__device__ __forceinline__ void p0a(Frame& F) {
    LAS float* coef = (LAS float*)(F.lds + P0_COEF); LAS float* red = (LAS float*)(F.lds + P0_RED);
    const float* c = F.in[1];
    for (int i = F.tid; i < 8 * 1024; i += NTHR) coef[i] = silu_f(c[i]);
    __syncthreads();
    float* MOD = WSP(float, WS_MOD);
    for (int it = F.vcu; it < 448; it += F.G) {
        if (it < 384) {
            const int l = it / 192, col0 = 32 * (it % 192); const float* mb = F.in[3] + l * 6144;
            gemv8_item(F.in[2] + (size_t)l * 1024 * 6144, 6144, 1024, col0, 32, coef, red, F.tid,
                       [&](int b, int cl, float s) { MOD[(l * 8 + b) * 6144 + col0 + cl] = s + mb[col0 + cl]; });
        } else {
            const int which = (it - 384) >> 5, kc = (it - 384) & 31; const float* pos = F.in[13 + which]; const float* w1 = F.in[which ? 17 : 15];
            const int n = F.tid & 255, hf = F.tid >> 8, kb = kc * 64 + hf * 32; float s = 0.f;
#pragma unroll 8
            for (int k = kb; k < kb + 32; ++k) s += pos[k] * w1[(size_t)k * 256 + n];
            red[hf * 256 + n] = s; __syncthreads();
            if (F.tid < 256) WSP(float, WS_DB)[((which * 32 + kc) << 8) + n] = red[n] + red[256 + n];
            __syncthreads();
        }
    }
    LAS float* scr = (LAS float*)(F.lds + P0_TSCR + F.wave * 8704);
    const int gw = F.vcu * NWAVES + F.wave, NGW = F.G * NWAVES;
    constexpr int I_ABIN = 16 * 112, I_ABOUT = 16 * 32, I_NSAIN = 16 * 88, I_NSAOUT = 16 * 32, I_UP = 16 * 176, I_DOWN = 44 * 32, I_CMP = 32 * 8;
    constexpr int NITEMS = I_ABIN + I_ABOUT + I_NSAIN + I_NSAOUT + 2 * I_UP + 2 * I_DOWN + 2 * I_CMP;
    for (int it = gw; it < NITEMS; it += NGW) {
        int r = it;
        if (r < I_ABIN) { transpose_item(F.in[6], 1024, ABN, WSP(bf16, WS_W_ABIN), 64 * (r / 112), 32 * (r % 112), 32 * (r % 112), 32, scr, F.lane); continue; } r -= I_ABIN;
        if (r < I_ABOUT) { transpose_item(F.in[7], 1024, 1024, WSP(bf16, WS_W_ABOUT), 64 * (r / 32), 32 * (r % 32), 32 * (r % 32), 32, scr, F.lane); continue; } r -= I_ABOUT;
        if (r < I_NSAIN) { int s0, nv; nsa_colmap(r % 88, s0, nv); transpose_item(F.in[11], 1024, 2608, WSP(bf16, WS_W_NSAIN), 64 * (r / 88), 32 * (r % 88), s0, nv, scr, F.lane); continue; } r -= I_NSAIN;
        if (r < I_NSAOUT) { transpose_item(F.in[12], 1024, 1024, WSP(bf16, WS_W_NSAOUT), 64 * (r / 32), 32 * (r % 32), 32 * (r % 32), 32, scr, F.lane); continue; } r -= I_NSAOUT;
        if (r < 2 * I_UP) { const int l = r / I_UP; r %= I_UP; const int nb = r % 176, tl = nb >> 3, wi = nb & 7, src0 = wi < 4 ? 128 * tl + 32 * wi : DFF + 128 * tl + 32 * (wi - 4); transpose_item(F.in[20] + (size_t)l * 1024 * UPN, 1024, UPN, WSP(bf16, WS_W_UP) + (size_t)l * UPN * 1024, 64 * (r / 176), 32 * nb, src0, 32, scr, F.lane); continue; } r -= 2 * I_UP;
        if (r < 2 * I_DOWN) { const int l = r / I_DOWN; r %= I_DOWN; transpose_item(F.in[22] + (size_t)l * DFF * 1024, DFF, 1024, WSP(bf16, WS_W_DOWN) + (size_t)l * 1024 * DFF, 64 * (r / 32), 32 * (r % 32), 32 * (r % 32), 32, scr, F.lane); continue; } r -= 2 * I_DOWN;
        { const int which = r / I_CMP; r %= I_CMP; transpose_item(F.in[which ? 17 : 15], 2048, 256, WSP(bf16, WS_W_CMP1) + (size_t)which * 256 * 2048, 64 * (r / 8), 32 * (r % 8), 32 * (r % 8), 32, scr, F.lane); }
    }
    const int gt = F.vcu * NTHR + F.tid;
    if (gt < 4096) { int bk = gt; if (gt >= 16) { const float x = log2f((float)gt * 0.0625f) * 2.6666667f + 1e-5f; bk = 16 + (int)floorf(x); if (bk > 31) bk = 31; } WSP(int, WS_BUCKET)[gt] = bk; }
    if (gt < 512) { const float a = F.in[8][gt], b2 = F.in[8][512 + gt]; const float mx = fmaxf(a, b2); const float ea = __expf(a - mx), eb = __expf(b2 - mx); WSP(float, WS_LB)[gt] = ea / (ea + eb); }
}

__device__ __forceinline__ void p0b(Frame& F) {
    LAS float* coef = (LAS float*)(F.lds + P0_COEF); LAS float* red = (LAS float*)(F.lds + P0_RED);
    const float* MOD = WSP(float, WS_MOD);
    int curm = -1;
    for (int it = F.vcu; it < 552; it += F.G) {
        int mid, r = it;
        if (r < 112) mid = 0; else if ((r -= 112) < 176) mid = 1; else if ((r -= 176) < 88) mid = 2; else { r -= 88; mid = 3; }
        if (mid != curm) {
            __syncthreads();
            const int l = mid >> 1, off = (mid & 1) ? 3072 : 0;
            for (int i = F.tid; i < 8192; i += NTHR) coef[i] = MOD[(l * 8 + (i >> 10)) * 6144 + off + (i & 1023)];
            __syncthreads(); curm = mid;
        }
        if (mid == 0) { float* o = WSP(float, WS_BV_ABIN); gemv8_item(F.in[6], ABN, 1024, 32 * r, 32, coef, red, F.tid, [&](int b, int cl, float s) { o[b * ABN + 32 * r + cl] = s; }); }
        else if (mid == 1) { float* o = WSP(float, WS_BV_UP0); gemv8_item(F.in[20], UPN, 1024, 32 * r, 32, coef, red, F.tid, [&](int b, int cl, float s) { o[b * UPN + 32 * r + cl] = s; }); }
        else if (mid == 2) { float* o = WSP(float, WS_BV_NSA); int s0, nv; nsa_colmap(r, s0, nv); gemv8_item(F.in[11], 2608, 1024, s0, nv, coef, red, F.tid, [&](int b, int cl, float s) { o[b * NSAN + 32 * r + cl] = s; }); }
        else { float* o = WSP(float, WS_BV_UP1); gemv8_item(F.in[20] + (size_t)1024 * UPN, UPN, 1024, 32 * r, 32, coef, red, F.tid, [&](int b, int cl, float s) { o[b * UPN + 32 * r + cl] = s; }); }
    }
    { const int gt = F.vcu * NTHR + F.tid; if (gt < 512) { const float* pp = WSP(float, WS_DB) + (((gt >> 8) * 32) << 8) + (gt & 255); float s = 0.f;
#pragma unroll 8
        for (int kc = 0; kc < 32; ++kc) s += pp[kc << 8];
        WSP(float, WS_CMPB)[gt] = s; } }
    const int gw = F.vcu * NWAVES + F.wave, NGW = F.G * NWAVES;
    const float* x = F.in[0]; const float* ng = F.in[4]; bf16* XS = WSP(bf16, WS_XS); float* SSQ = WSP(float, WS_SSQ);
    for (int m = gw; m < MTOK; m += NGW) {
        const int b = m >> 12; float ss = 0.f;
#pragma unroll
        for (int j = 0; j < 4; ++j) { const int col = 4 * F.lane + 256 * j;
            const f32x4 v = *(const f32x4*)(x + (size_t)m * DM + col); const f32x4 g4 = *(const f32x4*)(ng + col), s4 = *(const f32x4*)(MOD + b * 6144 + 1024 + col);
            ss += (v[0] * v[0] + v[1] * v[1]) + (v[2] * v[2] + v[3] * v[3]);
            const f32x4 y = v * (g4 * (1.f + s4)); u32x2 w; w.x = pkbf(y[0], y[1]); w.y = pkbf(y[2], y[3]);
            *(u32x2*)(XS + (size_t)m * DM + col) = w; }
        ss = wave_sum(ss);
        if (F.lane < 16) SSQ[(size_t)m * 16 + F.lane] = F.lane == 0 ? ss : 0.f;
    }
}

__device__ __forceinline__ void hgrn_s1_unit(Frame& F, int u) {
    const int bh = u >> 6, c = u & 63, b = bh >> 2, h = bh & 3; const size_t row0 = (size_t)b * SEQ + 64 * c;
    LAS float* SEGT = (LAS float*)(F.lds); LAS bf16* KT = (LAS bf16*)(F.lds + 2048); LAS bf16* VT = (LAS bf16*)(F.lds + 2048 + 18432);
    const int tid = F.tid, k = tid & 127, seg = tid >> 7;
    float kk[16], bl[16]; float acc = 0.f;
    { const float* lfp = WSP(float, WS_LF) + (row0 + 16 * seg) * HGW + h * 128 + k;
#pragma unroll
      for (int i = 0; i < 16; ++i) { const float v = lfp[(size_t)i * HGW]; kk[i] = 1.f - __expf(v); acc += v; bl[i] = acc; } }
    SEGT[seg * 128 + k] = acc;
    { const bf16* ivp = WSP(bf16, WS_IV) + row0 * HGW + h * 128;
#pragma unroll
      for (int rnd = 0; rnd < 2; ++rnd) { const int idx = tid + NTHR * rnd, s = idx >> 4, ch = idx & 15; const v4u v = *(const v4u*)(ivp + (size_t)s * HGW + 8 * ch);
#pragma unroll
          for (int e = 0; e < 8; ++e) VT[(8 * ch + e) * 72 + s] = (bf16)((e & 1) ? (v[e >> 1] >> 16) : (v[e >> 1] & 0xffffu)); } }
    __syncthreads();
    float pre = 0.f, tot = 0.f;
#pragma unroll
    for (int s2 = 0; s2 < 4; ++s2) { const float x = SEGT[s2 * 128 + k]; tot += x; if (s2 < seg) pre += x; }
    { unsigned pk[8];
#pragma unroll
      for (int i = 0; i < 16; i += 2) pk[i >> 1] = pkbf(kk[i] * __expf(tot - (bl[i] + pre)), kk[i + 1] * __expf(tot - (bl[i + 1] + pre)));
      *(LAS v4u*)(KT + k * 72 + 16 * seg) = (v4u){pk[0], pk[1], pk[2], pk[3]}; *(LAS v4u*)(KT + k * 72 + 16 * seg + 8) = (v4u){pk[4], pk[5], pk[6], pk[7]}; }
    if (seg == 0) WSP(float, WS_DB)[(size_t)u * 128 + k] = __expf(tot);
    __syncthreads();
    const int r = F.lane & 31, hh = F.lane >> 5, ti = F.wave >> 1;
    bf16* up = WSP(bf16, WS_UB) + (size_t)u * 16384;
#pragma unroll
    for (int tt = 0; tt < 2; ++tt) { const int tj = 2 * (F.wave & 1) + tt; f32x16 a16 = {};
#pragma unroll
        for (int ks = 0; ks < 4; ++ks) { const bf16x8 a = *(const LAS bf16x8*)(KT + (32 * ti + r) * 72 + 16 * ks + 8 * hh), bb = *(const LAS bf16x8*)(VT + (32 * tj + r) * 72 + 16 * ks + 8 * hh); a16 = MFMA32(a, bb, a16); }
#pragma unroll
        for (int reg = 0; reg < 16; ++reg) up[(32 * ti + crow(reg, hh)) * 128 + 32 * tj + r] = tobf(a16[reg]); }
    __syncthreads();
}
__device__ __forceinline__ void hgrn_s2(Frame& F) {
    unsigned* UB = WSP(unsigned, WS_UB); const float* DB = WSP(float, WS_DB);
    for (int idx = F.vcu * NTHR + F.tid; idx < 32 * 8192; idx += F.G * NTHR) {
        const int bh = idx >> 13, e = idx & 8191, k = e >> 6, v2 = e & 63;
        unsigned* p = UB + (size_t)bh * 64 * 8192 + k * 64 + v2; const float* dp = DB + (size_t)bh * 64 * 128 + k;
        float s0 = 0.f, s1 = 0.f;
#pragma unroll 8
        for (int c = 0; c < 64; ++c) { const unsigned uu = p[(size_t)c * 8192]; const float dd = dp[c * 128]; p[(size_t)c * 8192] = pkbf(s0, s1); s0 = dd * s0 + bflo(uu); s1 = dd * s1 + bfhi(uu); }
    }
}
__device__ __forceinline__ void hgrn_s3_unit(Frame& F, int u) {
    const int bh = u >> 6, c = u & 63, b = bh >> 2, h = bh & 3; const size_t row0 = (size_t)b * SEQ + 64 * c;
    LAS float* SEGT = (LAS float*)(F.lds); LAS float* SSQP = (LAS float*)(F.lds + 2048);
    LAS bf16* QP = (LAS bf16*)(F.lds + 4096); LAS bf16* KP = (LAS bf16*)(F.lds + 21504); LAS bf16* AM = (LAS bf16*)(F.lds + 38912);
    LAS bf16* VT = (LAS bf16*)(F.lds + 48128); LAS bf16* ST = (LAS bf16*)(F.lds + 66560);
    const int tid = F.tid, k = tid & 127, seg = tid >> 7;
    float kk[16], bl[16], qv[16]; float acc = 0.f;
    { const float* lfp = WSP(float, WS_LF) + (row0 + 16 * seg) * HGW + h * 128 + k; const bf16* qp = WSP(bf16, WS_QH) + (row0 + 16 * seg) * HGW + h * 128 + k;
#pragma unroll
      for (int i = 0; i < 16; ++i) { const float v = lfp[(size_t)i * HGW]; qv[i] = bf2f(qp[(size_t)i * HGW]); kk[i] = 1.f - __expf(v); acc += v; bl[i] = acc; } }
    SEGT[seg * 128 + k] = acc;
    { const bf16* ivp = WSP(bf16, WS_IV) + row0 * HGW + h * 128;
#pragma unroll
      for (int rnd = 0; rnd < 2; ++rnd) { const int idx = tid + NTHR * rnd, s = idx >> 4, ch = idx & 15; const v4u v = *(const v4u*)(ivp + (size_t)s * HGW + 8 * ch);
#pragma unroll
          for (int e = 0; e < 8; ++e) VT[(8 * ch + e) * 72 + s] = (bf16)((e & 1) ? (v[e >> 1] >> 16) : (v[e >> 1] & 0xffffu)); }
      const bf16* sp = WSP(bf16, WS_UB) + (size_t)u * 16384;
#pragma unroll
      for (int rnd = 0; rnd < 4; ++rnd) { const int idx = tid + NTHR * rnd, k2 = idx >> 4, ch = idx & 15; const v4u v = *(const v4u*)(sp + k2 * 128 + 8 * ch);
#pragma unroll
          for (int e = 0; e < 8; ++e) ST[(8 * ch + e) * 136 + k2] = (bf16)((e & 1) ? (v[e >> 1] >> 16) : (v[e >> 1] & 0xffffu)); } }
    __syncthreads();
    float pre = 0.f;
#pragma unroll
    for (int s2 = 0; s2 < 4; ++s2) { const float x = SEGT[s2 * 128 + k]; if (s2 < seg) pre += x; }
#pragma unroll
    for (int i = 0; i < 16; ++i) { const float bi = bl[i] + pre; QP[(16 * seg + i) * 136 + k] = tobf(qv[i] * __expf(bi)); KP[(16 * seg + i) * 136 + k] = tobf(kk[i] * __expf(-bi)); }
    __syncthreads();
    const int r = F.lane & 31, hh = F.lane >> 5, w = F.wave;
    if (w < 3) { const int ti = w ? 1 : 0, tj = w == 2 ? 1 : 0; f32x16 a16 = {};
#pragma unroll
        for (int ks = 0; ks < 8; ++ks) { const bf16x8 a = *(const LAS bf16x8*)(QP + (32 * ti + r) * 136 + 16 * ks + 8 * hh), bb = *(const LAS bf16x8*)(KP + (32 * tj + r) * 136 + 16 * ks + 8 * hh); a16 = MFMA32(a, bb, a16); }
#pragma unroll
        for (int reg = 0; reg < 16; ++reg) { const int t = 32 * ti + crow(reg, hh), s = 32 * tj + r; AM[t * 72 + s] = tobf(s <= t ? a16[reg] : 0.f); }
    } else if (w == 3) {
#pragma unroll
        for (int reg = 0; reg < 16; ++reg) AM[crow(reg, hh) * 72 + 32 + r] = 0;
    }
    __syncthreads();
    const int ti = w >> 2, tj = w & 3; f32x16 o16 = {};
#pragma unroll
    for (int ks = 0; ks < 4; ++ks) { const bf16x8 a = *(const LAS bf16x8*)(AM + (32 * ti + r) * 72 + 16 * ks + 8 * hh), bb = *(const LAS bf16x8*)(VT + (32 * tj + r) * 72 + 16 * ks + 8 * hh); o16 = MFMA32(a, bb, o16); }
#pragma unroll
    for (int ks = 0; ks < 8; ++ks) { const bf16x8 a = *(const LAS bf16x8*)(QP + (32 * ti + r) * 136 + 16 * ks + 8 * hh), bb = *(const LAS bf16x8*)(ST + (32 * tj + r) * 136 + 16 * ks + 8 * hh); o16 = MFMA32(a, bb, o16); }
#pragma unroll
    for (int reg = 0; reg < 16; ++reg) { float x = o16[reg] * o16[reg]; x += __shfl_xor(x, 1); x += __shfl_xor(x, 2); x += __shfl_xor(x, 4); x += __shfl_xor(x, 8); x += __shfl_xor(x, 16);
        if (r == 0) SSQP[(32 * ti + crow(reg, hh)) * 4 + tj] = x; }
    __syncthreads();
    { const int v = 32 * tj + r; const float og = F.in[9][v]; const bf16* gsp = WSP(bf16, WS_GS) + row0 * HGW + h * 128 + v; bf16* aop = WSP(bf16, WS_AO) + row0 * DM + h * 128 + v;
#pragma unroll
      for (int reg = 0; reg < 16; ++reg) { const int t = 32 * ti + crow(reg, hh); const float rs = rsqrtf(((SSQP[t * 4] + SSQP[t * 4 + 1]) + (SSQP[t * 4 + 2] + SSQP[t * 4 + 3])) * (1.f / 128.f) + EPSN);
          aop[(size_t)t * DM] = tobf(o16[reg] * rs * og * bf2f(gsp[(size_t)t * HGW])); } }
    __syncthreads();
}
__device__ __forceinline__ void sconv_pass(Frame& F) {
    const bf16 *GBp = WSP(bf16, WS_GB), *GCp = WSP(bf16, WS_GC), *SVp = WSP(bf16, WS_SV); bf16* AO = WSP(bf16, WS_AO); const float* cw = F.in[10];
    for (int idx = F.vcu * NTHR + F.tid; idx < MTOK * 64; idx += F.G * NTHR) {
        const int row = idx >> 6, col = (idx & 63) * 8, t = row & (SEQ - 1); const size_t o0 = (size_t)row * HGW + col;
        const v4u gb = *(const v4u*)(GBp + o0); v4u c0 = *(const v4u*)(GCp + o0), s0 = *(const v4u*)(SVp + o0), c1 = {}, s1 = {}, c2 = {}, s2 = {};
        if (t >= 1) { c1 = *(const v4u*)(GCp + o0 - HGW); s1 = *(const v4u*)(SVp + o0 - HGW); }
        if (t >= 2) { c2 = *(const v4u*)(GCp + o0 - 2 * HGW); s2 = *(const v4u*)(SVp + o0 - 2 * HGW); }
        float o[8];
#pragma unroll
        for (int e = 0; e < 8; ++e) { const int q = e >> 1; const bool hi = e & 1;
            const float u0 = (hi ? bfhi(c0[q]) : bflo(c0[q])) * (hi ? bfhi(s0[q]) : bflo(s0[q])), u1 = (hi ? bfhi(c1[q]) : bflo(c1[q])) * (hi ? bfhi(s1[q]) : bflo(s1[q])), u2 = (hi ? bfhi(c2[q]) : bflo(c2[q])) * (hi ? bfhi(s2[q]) : bflo(s2[q]));
            o[e] = (hi ? bfhi(gb[q]) : bflo(gb[q])) * (cw[col + e] * u2 + cw[512 + col + e] * u1 + cw[1024 + col + e] * u0); }
        *(v4u*)(AO + (size_t)row * DM + 512 + col) = (v4u){pkbf(o[0], o[1]), pkbf(o[2], o[3]), pkbf(o[4], o[5]), pkbf(o[6], o[7])};
    }
}
__device__ __forceinline__ void ffn_fixup_pass(Frame& F, const float* cw) {
    const float* SIDE = WSP(float, WS_SIDE); bf16* Hp = WSP(bf16, WS_UP);
    for (int idx = F.vcu * NTHR + F.tid; idx < 128 * DFF; idx += F.G * NTHR) {
        const int pm = idx / DFF, col = idx % DFF; const float* s = SIDE + (size_t)pm * 6 * DFF + col;
        float gm2 = 0.f, gm1 = 0.f;
        if (pm & 15) { gm2 = s[-6 * DFF]; gm1 = s[-5 * DFF]; }
        const float g0 = s[2 * DFF], g1 = s[3 * DFF], u0 = s[4 * DFF], u1 = s[5 * DFF], w0 = cw[col], w1 = cw[DFF + col], w2 = cw[2 * DFF + col];
        Hp[(size_t)(pm * 256) * DFF + col] = tobf(silu_f(w0 * gm2 + w1 * gm1 + w2 * g0) * u0);
        Hp[(size_t)(pm * 256 + 1) * DFF + col] = tobf(silu_f(w0 * gm1 + w1 * g0 + w2 * g1) * u1);
    }
}
__device__ __forceinline__ void cmp2_pass(Frame& F) {
    for (int idx = F.vcu * NTHR + F.tid; idx < 2 * 8192 * 64; idx += F.G * NTHR) {
        const int which = idx >> 19, r = (idx >> 6) & 8191, d = idx & 63; float s = 0.f;
        if ((r & 255) < 255) { const v4u* hp = (const v4u*)(WSP(bf16, WS_HID) + ((size_t)which * 8192 + r) * 256); const float* w2 = F.in[which ? 18 : 16] + d;
#pragma unroll 4
            for (int n8 = 0; n8 < 32; ++n8) { const v4u hv = hp[n8];
#pragma unroll
                for (int q = 0; q < 4; ++q) { s += bflo(hv[q]) * w2[(8 * n8 + 2 * q) * 64]; s += bfhi(hv[q]) * w2[(8 * n8 + 2 * q + 1) * 64]; } } }
        WSP(bf16, which ? WS_VCMP : WS_KCMP)[(size_t)r * 64 + d] = tobf(s);
    }
}
__device__ __forceinline__ void final_pass(Frame& F) {
    const int gw = F.vcu * NWAVES + F.wave, NGW = F.G * NWAVES; const float* fg = F.in[23];
    for (int m = gw; m < MTOK; m += NGW) { f32x4 v[4]; float ss = 0.f;
#pragma unroll
        for (int j = 0; j < 4; ++j) { v[j] = *(const f32x4*)(F.out + (size_t)m * DM + 4 * F.lane + 256 * j); ss += (v[j][0] * v[j][0] + v[j][1] * v[j][1]) + (v[j][2] * v[j][2] + v[j][3] * v[j][3]); }
        const float rs = rsqrtf(wave_sum(ss) * (1.f / DM) + EPSN);
#pragma unroll
        for (int j = 0; j < 4; ++j) *(f32x4*)(F.out + (size_t)m * DM + 4 * F.lane + 256 * j) = v[j] * rs * *(const f32x4*)(fg + 4 * F.lane + 256 * j); }
}

constexpr int AT_LUT = 0, AT_LUTN = 1096, AT_KV = 17536, AT_TILE = 9216, AT_IA = AT_KV + 4 * AT_TILE, AT_IB = AT_IA + 16384, AT_SEL = AT_IB + 16640, AT_WOR = AT_SEL + 512, AT_WSF = AT_WOR + 64, AT_END = AT_WSF + 8 * 32 * 4;
static_assert(AT_END <= RING_BYTES, "attention LDS");
#define AT_KB(buf) (AT_KV + (buf) * 2 * AT_TILE)
#define AT_VB(buf) (AT_KV + (buf) * 2 * AT_TILE + AT_TILE)
typedef short v4i16_t __attribute__((ext_vector_type(4)));
__device__ __forceinline__ void at_scores(f32x16& p, const LAS unsigned char* kt, const bf16x8 (&qr)[4], int c, int h, int sub) {
    p = (f32x16){};
    const LAS unsigned char* kb = kt + (32 * sub + c) * 144 + h * 16;
#pragma unroll
    for (int ks = 0; ks < 4; ++ks) { const bf16x8 a0 = *(const LAS bf16x8*)(kb + ks * 32); p = MFMA32(a0, qr[ks], p); }
}
__device__ __forceinline__ bf16x8 pack8(const f32x16& p, int s) {
    v4u w; w.x = pkbf(p[8 * s], p[8 * s + 1]); w.y = pkbf(p[8 * s + 2], p[8 * s + 3]); w.z = pkbf(p[8 * s + 4], p[8 * s + 5]); w.w = pkbf(p[8 * s + 6], p[8 * s + 7]);
    return __builtin_bit_cast(bf16x8, w);
}
__device__ __forceinline__ void at_pv(const f32x16& p, f32x16 (&o)[2], const LAS unsigned char* vt, int lane, int sub) {
    const int h = lane >> 5, i16 = lane & 15;
    const LAS unsigned char* vb = vt + (32 * sub + 4 * h + (i16 >> 2)) * 144 + (((lane >> 4) & 1) * 16 + (i16 & 3) * 4) * 2;
#pragma unroll
    for (int s = 0; s < 2; ++s) { const bf16x8 A = pack8(p, s);
#pragma unroll
        for (int db = 0; db < 2; ++db) { const LAS unsigned char* bp = vb + (16 * s) * 144 + db * 64;
            const s16x4 lo = __builtin_bit_cast(s16x4, __builtin_amdgcn_ds_read_tr16_b64_v4i16((LAS v4i16_t*)(bp)));
            const s16x4 hi = __builtin_bit_cast(s16x4, __builtin_amdgcn_ds_read_tr16_b64_v4i16((LAS v4i16_t*)(bp + 8 * 144)));
            const bf16x8 B = __builtin_shufflevector(lo, hi, 0, 1, 2, 3, 4, 5, 6, 7); o[db] = MFMA32(A, B, o[db]); } }
}
__device__ __forceinline__ float xhalf_max(float v) { auto rr = __builtin_amdgcn_permlane32_swap(__float_as_uint(v), __float_as_uint(v), false, false); return fmaxf(__uint_as_float(rr[0]), __uint_as_float(rr[1])); }
__device__ __forceinline__ float xhalf_sum(float v) { auto rr = __builtin_amdgcn_permlane32_swap(__float_as_uint(v), __float_as_uint(v), false, false); return __uint_as_float(rr[0]) + __uint_as_float(rr[1]); }
__device__ __forceinline__ void at_softmax(f32x16& sc, float& m, float& l, f32x16 (&o)[2], LAS float* wsf, int c, int h, bool rescale_o) {
    float mx = fmaxf(fmaxf(sc[0], sc[1]), sc[2]);
#pragma unroll
    for (int r = 3; r < 15; r += 2) mx = fmaxf(fmaxf(mx, sc[r]), sc[r + 1]);
    mx = xhalf_max(fmaxf(mx, sc[15]));
    const float mn = fmaxf(m, mx), alpha = __builtin_amdgcn_exp2f(m - mn);
    const bool grew = mn != m; m = mn;
    float sum = 0.f;
#pragma unroll
    for (int r = 0; r < 16; ++r) { sc[r] = __builtin_amdgcn_exp2f(sc[r] - mn); sum += sc[r]; }
    l = l * alpha + xhalf_sum(sum);
    if (rescale_o && __any(grew)) {
        if (h == 0) wsf[c] = alpha;
#pragma unroll
        for (int r = 0; r < 16; ++r) { const float a = wsf[crow(r, h)]; o[0][r] *= a; o[1][r] *= a; }
    }
}
__device__ __forceinline__ void at_accum(f32x16 (&acc)[2], const f32x16 (&o)[2], float fac, LAS float* wsf, int c, int h) {
    if (h == 0) wsf[c] = fac;
#pragma unroll
    for (int r = 0; r < 16; ++r) { const float a = wsf[crow(r, h)]; acc[0][r] += o[0][r] * a; acc[1][r] += o[1][r] * a; }
}
struct AtState { float m, l; f32x16 o[2]; };
template <int MODE> __device__ __forceinline__ void at_branch(Frame& F, unsigned long long tmask, const bf16* kp, const bf16* vp, int& buf, const bf16x8 (&qr)[4], AtState& st,
                                                              int t, int qb, int q, int i, unsigned long long mysel, float inv_l) {
    LAS unsigned char* lds = F.lds;
    int tid = F.tid; asm volatile("" : "+v"(tid));
    const int lane = tid & 63, c = lane & 31, h = lane >> 5;
    LAS float* wsf = (LAS float*)(lds + AT_WSF) + F.wave * 32;
    const int lrow = tid >> 3, lch = tid & 7; const size_t goff = (size_t)lrow * 64 + lch * 8; const int loff = lrow * 144 + lch * 16;
    const float NEG = -INFINITY;
    const LAS float* LUTi = (const LAS float*)(lds + AT_LUT) + i * AT_LUTN + 64;
    if (tmask == 0ull) return;
    int s = __builtin_ctzll(tmask);
    v4u kreg = *(const v4u*)(kp + (size_t)s * 4096 + goff), vreg = {};
    if (MODE != 0) vreg = *(const v4u*)(vp + (size_t)s * 4096 + goff);
    for (;;) {
        *(LAS v4u*)(lds + AT_KB(buf) + loff) = kreg; if (MODE != 0) *(LAS v4u*)(lds + AT_VB(buf) + loff) = vreg;
        __syncthreads();
        tmask &= tmask - 1ull; const bool more = tmask != 0ull; const int sn = more ? __builtin_ctzll(tmask) : s;
        if (more) { kreg = *(const v4u*)(kp + (size_t)sn * 4096 + goff); if (MODE != 0) vreg = *(const v4u*)(vp + (size_t)sn * 4096 + goff); }
        const LAS unsigned char* kt = lds + AT_KB(buf); const LAS unsigned char* vt = lds + AT_VB(buf);
        const bool rs = MODE == 2 ? (bool)((mysel >> s) & 1ull) : true;
        if (MODE != 2 || __ballot(rs) != 0ull) {
#pragma unroll
            for (int sub = 0; sub < 2; ++sub) {
                f32x16 p; float bv[16];
                if (MODE == 0 || MODE == 1) {
                    const int dbase = t - (1024 * s + 512 * sub + 64 * h + 31);
#pragma unroll
                    for (int r = 0; r < 16; ++r) { const int d0 = dbase - 16 * ((r & 3) + 8 * (r >> 2)); bv[r] = LUTi[min(max(d0, -1), 1023)]; }
                } else if (MODE == 2 && qb - s >= 14) {
                    const float bfar = rs ? LUTi[1023] : NEG;
#pragma unroll
                    for (int r = 0; r < 16; ++r) bv[r] = bfar;
                } else if (MODE == 2 || s != qb - 8) {
                    const int dbase = rs ? t - (64 * s + 32 * sub + 4 * h) : -37;
                    const LAS float* lp = LUTi + dbase - 27;
#pragma unroll
                    for (int r = 0; r < 16; ++r) bv[r] = lp[27 - ((r & 3) + 8 * (r >> 2))];
                } else {
                    const int dbase = t - (64 * s + 32 * sub + 4 * h);
#pragma unroll
                    for (int r = 0; r < 16; ++r) { const int d0 = dbase - ((r & 3) + 8 * (r >> 2)); bv[r] = LUTi[d0 < 512 ? d0 : -1]; }
                }
                at_scores(p, kt, qr, c, h, sub);
                if (MODE == 1) {
#pragma unroll
                    for (int r = 0; r < 16; ++r) p[r] = __builtin_amdgcn_exp2f(p[r] + bv[r] - st.m) * inv_l;
                    LAS float* IA = (LAS float*)(lds + AT_IA); LAS float* IB = (LAS float*)(lds + AT_IB);
#pragma unroll
                    for (int gq = 0; gq < 4; ++gq) {
                        float pb = 0.5f * p[4 * gq + 3], pa = (p[4 * gq] + p[4 * gq + 1]) + (p[4 * gq + 2] + pb);
                        pa += __shfl_xor(pa, 8); pa += __shfl_xor(pa, 16); pb += __shfl_xor(pb, 8); pb += __shfl_xor(pb, 16);
                        const int sb = 16 * s + 8 * sub + 2 * gq + h;
                        if (i == 0) { IA[q * 64 + sb] = pa; IB[q * 65 + sb + 1] = pb; } }
                    at_pv(p, st.o, vt, lane, sub);
                } else {
#pragma unroll
                    for (int r = 0; r < 16; ++r) p[r] += bv[r];
                    at_softmax(p, st.m, st.l, st.o, wsf, c, h, MODE != 0);
                    if (MODE != 0) at_pv(p, st.o, vt, lane, sub);
                }
            }
        }
        buf ^= 1;
        if (!more) break;
        s = sn;
    }
}

__device__ __forceinline__ void attn_unit(Frame& F, int b, int g, int qb, int& buf) {
    LAS unsigned char* lds = F.lds;
    LAS float* IA = (LAS float*)(lds + AT_IA); LAS float* IB = (LAS float*)(lds + AT_IB);
    LAS unsigned* SEL = (LAS unsigned*)(lds + AT_SEL); LAS unsigned* WOR = (LAS unsigned*)(lds + AT_WOR);
    const int tid = F.tid, lane = F.lane, w = F.wave, c = lane & 31, h = lane >> 5, i = c >> 3, q = 8 * w + (c & 7);
    LAS float* wsf = (LAS float*)(lds + AT_WSF) + w * 32;
    const int t0 = 64 * qb, t = t0 + q; const size_t rowbase = (size_t)b * SEQ;
    const bf16* KV6 = WSP(bf16, WS_KV6);
    const bf16* kc = WSP(bf16, WS_KCMP) + (size_t)(b * 4 + g) * 256 * 64; const bf16* vc = WSP(bf16, WS_VCMP) + (size_t)(b * 4 + g) * 256 * 64;
    const bf16* ksp = KV6 + (size_t)((2 * BATCH + b) * 4 + g) * KVPANEL; const bf16* vsp = KV6 + (size_t)((3 * BATCH + b) * 4 + g) * KVPANEL;
    const bf16* kwp = KV6 + (size_t)((4 * BATCH + b) * 4 + g) * KVPANEL; const bf16* vwp = KV6 + (size_t)((5 * BATCH + b) * 4 + g) * KVPANEL;
    bf16x8 qr[4];
    { const bf16* qp = WSP(bf16, WS_QN) + (rowbase + t) * DM + (g * 4 + i) * 64 + 8 * h;
#pragma unroll
      for (int ks = 0; ks < 4; ++ks) qr[ks] = *(const bf16x8*)(qp + 16 * ks); }
    const float* gp = WSP(float, WS_GATES) + (rowbase + t) * 48 + g * 4 + i;
    const float gate_c = gp[0], gate_s = gp[16], gate_w = gp[32];
    __syncthreads();
    for (int x = tid; x < 64 * 64; x += NTHR) IA[x] = 0.f;
    for (int x = tid; x < 64 * 65; x += NTHR) IB[x] = 0.f;
    f32x16 acc[2]; acc[0] = (f32x16){}; acc[1] = (f32x16){};
    AtState st;
    const int ntc = (4 * qb + 3 + 63) >> 6; const unsigned long long cmask = (1ull << ntc) - 1ull;
    st.m = -1e30f; st.l = 0.f; st.o[0] = (f32x16){}; st.o[1] = (f32x16){};
    at_branch<0>(F, cmask, kc, vc, buf, qr, st, t, qb, q, i, 0ull, 0.f);
    at_branch<1>(F, cmask, kc, vc, buf, qr, st, t, qb, q, i, 0ull, st.l > 0.f ? 1.f / st.l : 0.f);
    at_accum(acc, st.o, gate_c, wsf, c, h);
    __syncthreads();
    { const int cur = qb; unsigned long long wor = 0ull;
      for (int qq = 0; qq < 8; ++qq) { const int q2 = 8 * w + qq;
          const bool forced = (lane == 0) || (lane == cur) || (lane == cur - 1);
          const float mine = forced ? INFINITY : IA[q2 * 64 + lane] + IB[q2 * 65 + lane];
          int rank = 0;
          for (int s2 = 0; s2 <= cur; ++s2) { const float ov = __builtin_bit_cast(float, __builtin_amdgcn_readlane(__builtin_bit_cast(int, mine), s2));
              rank += (ov > mine || (ov == mine && s2 < lane)) ? 1 : 0; }
          const unsigned long long mask = __ballot(lane <= cur && rank < 16);
          if (lane == 0) { SEL[2 * q2] = (unsigned)mask; SEL[2 * q2 + 1] = (unsigned)(mask >> 32); }
          wor |= mask; }
      if (lane == 0) { WOR[2 * w] = (unsigned)wor; WOR[2 * w + 1] = (unsigned)(wor >> 32); } }
    __syncthreads();
    { unsigned long long uni = 0ull;
#pragma unroll
      for (int x = 0; x < 8; ++x) uni |= (unsigned long long)WOR[2 * x] | ((unsigned long long)WOR[2 * x + 1] << 32);
      const unsigned long long mysel = (unsigned long long)SEL[2 * q] | ((unsigned long long)SEL[2 * q + 1] << 32);
      st.m = -1e30f; st.l = 0.f; st.o[0] = (f32x16){}; st.o[1] = (f32x16){};
      at_branch<2>(F, uni, ksp, vsp, buf, qr, st, t, qb, q, i, mysel, 0.f);
      at_accum(acc, st.o, st.l > 0.f ? gate_s / st.l : 0.f, wsf, c, h);
    }
    { const int lo = max(0, qb - 8); const unsigned long long wmask = ((qb == 63 ? ~0ull : ((1ull << (qb + 1)) - 1ull)) >> lo) << lo;
      st.m = -1e30f; st.l = 0.f; st.o[0] = (f32x16){}; st.o[1] = (f32x16){};
      at_branch<3>(F, wmask, kwp, vwp, buf, qr, st, t, qb, q, i, 0ull, 0.f);
      at_accum(acc, st.o, st.l > 0.f ? gate_w / st.l : 0.f, wsf, c, h);
    }
    { bf16* AO = WSP(bf16, WS_AO);
#pragma unroll
      for (int r = 0; r < 16; ++r) { const int cc = crow(r, h), i2 = cc >> 3, t2 = t0 + 8 * w + (cc & 7); bf16* op = AO + (rowbase + t2) * DM + (g * 4 + i2) * 64 + c;
          op[0] = tobf(acc[0][r]); op[32] = tobf(acc[1][r]); } }
}
__device__ __forceinline__ void attn_phase(Frame& F) {
    LAS float* LUT = (LAS float*)(F.lds + AT_LUT); const int* bucket = WSP(int, WS_BUCKET); const float* rb = F.in[19];
    int curg = -1, buf = 0;
    for (int u = F.vcu; u < 2048; u += F.G) {
        const int v = u & 255, k = u >> 8, g = v >> 6, j = v & 63, a = j >> 3, rp = j & 7;
        const int b = (a + k) & 7, base = 16 * (k >> 1), qb = (k & 1) ? base + 15 - rp : base + rp;
        if (g != curg) { __syncthreads();
            for (int x = F.tid; x < 4 * AT_LUTN; x += NTHR) { const int hd = x / AT_LUTN, d = x % AT_LUTN - 64; LUT[x] = d < 0 ? -INFINITY : rb[bucket[d] * 16 + g * 4 + hd] * LOG2E; }
            __syncthreads(); curg = g; }
        attn_unit(F, b, g, qb, buf);
    }
}

constexpr int NPHASE = 19;
struct Args { const float* in[24]; float* out; unsigned char* ws; int ph_lo, ph_hi, li, pad; };
__global__ void __launch_bounds__(NTHR, 2) fwd_kernel(Args args) {
    extern __shared__ __attribute__((aligned(16))) unsigned char lds_raw[];
    Frame F;
    F.lds = (LAS unsigned char*)lds_raw;
    F.tid = threadIdx.x; F.lane = F.tid & 63; F.wave = __builtin_amdgcn_readfirstlane(F.tid >> 6);
    F.G = gridDim.x; { const int bx = blockIdx.x; F.vcu = (F.G % 8 == 0) ? (bx % 8) * (F.G / 8) + bx / 8 : bx; }
    F.in = args.in; F.out = args.out; F.ws = args.ws;
    const int lo = args.ph_lo, hi = args.ph_hi;
    for (int u = F.tid; u < (LDS_BYTES - LDSCTL_OFF) / 4; u += NTHR) ((LAS unsigned*)(F.lds + LDSCTL_OFF))[u] = 0u;
    __syncthreads();
    XcdBarrier bar = xcd_barrier_post((unsigned*)(F.ws + WS_CTL) + CW_BAR, (volatile LAS unsigned*)(F.lds + MISC_OFF) + 8);
#ifndef REP_MASK
#define REP_MASK 0
#endif
#define NREP(k) ((((REP_MASK) >> (k)) & 1) ? 2 : 1)
#ifdef PH_MASK
#define IN(k) ((((PH_MASK) >> (k)) & 1) && lo <= (k) && (k) < hi)
#else
#define IN(k) (lo <= (k) && (k) < hi)
#endif
#define SEAM(k) do { if (IN(k) && IN((k) + 1)) { if ((k) == 0) cg::this_grid().sync(); else xcd_barrier(bar); } asm volatile("" : "+v"(F.tid)); F.lane = F.tid & 63; F.wave = __builtin_amdgcn_readfirstlane(F.tid >> 6); } while (0)
    float* MOD = WSP(float, WS_MOD); float* SSQ = WSP(float, WS_SSQ);
    if (IN(0)) for (int rp_ = 0; rp_ < NREP(0); ++rp_) { p0a(F); } SEAM(0);
    if (IN(1)) for (int rp_ = 0; rp_ < NREP(1); ++rp_) { p0b(F); } SEAM(1);
    if (IN(2)) for (int rp_ = 0; rp_ < NREP(2); ++rp_) {
        pg8::Gemm g{WSP(bf16, WS_XS), WSP(bf16, WS_W_ABIN), MTOK, ABN, 1024, 1024}; StaticOrderRs S; S.init(MTOK, ABN, F.G, (int)blockIdx.x); S.ssq = SSQ; S.tab = (LAS float*)(F.lds + RSTD_OFF); S.tid = F.tid; S.cnt = 0;
        EpiAbIn E{(const LAS float*)(F.lds + RSTD_OFF), WSP(float, WS_BV_ABIN), WSP(float, WS_LB), WSP(bf16, WS_QH), WSP(bf16, WS_IV), WSP(bf16, WS_GS), WSP(bf16, WS_GB), WSP(bf16, WS_GC), WSP(bf16, WS_SV), WSP(float, WS_LF), 0};
        pg8::gemm_phase<EpiAbIn, StaticOrderRs, true, true>(F.lds, g, S, E, F.tid);
    } SEAM(2);
    if (IN(3)) for (int rp_ = 0; rp_ < NREP(3); ++rp_) { for (int u = F.vcu; u < 2048; u += F.G) hgrn_s1_unit(F, u); sconv_pass(F); } SEAM(3);
    if (IN(4)) { hgrn_s2(F); } SEAM(4);
    if (IN(5)) for (int rp_ = 0; rp_ < NREP(5); ++rp_) { for (int u = F.vcu; u < 2048; u += F.G) hgrn_s3_unit(F, u); } SEAM(5);
    if (IN(6)) for (int rp_ = 0; rp_ < NREP(6); ++rp_) {
        pg8::Gemm g{WSP(bf16, WS_AO), WSP(bf16, WS_W_ABOUT), MTOK, 1024, 1024, 1024}; pg8::StaticOrder S; S.init(MTOK, 1024, F.G, (int)blockIdx.x);
        EpiRes E{F.in[0], F.out, WSP(bf16, WS_XS), MOD + 2048, F.in[5], MOD + 4096, SSQ, 1};
        pg8::gemm_phase<EpiRes, pg8::StaticOrder, true, true>(F.lds, g, S, E, F.tid);
    } SEAM(6);
    for (int l = 0; l < 2; ++l) {
        const int p = l == 0 ? 7 : 15;
        if (IN(p)) for (int rp_ = 0; rp_ < NREP(7); ++rp_) {
            pg8::Gemm g{WSP(bf16, WS_XS), WSP(bf16, WS_W_UP) + (size_t)l * UPN * 1024, MTOK, UPN, 1024, 1024}; StaticOrderRs S; S.init(MTOK, UPN, F.G, (int)blockIdx.x); S.ssq = SSQ; S.tab = (LAS float*)(F.lds + RSTD_OFF); S.tid = F.tid; S.cnt = 0;
            EpiUpConv E{(const LAS float*)(F.lds + RSTD_OFF), WSP(float, l ? WS_BV_UP1 : WS_BV_UP0), F.in[21] + (size_t)l * 3 * DFF, WSP(bf16, WS_UP), WSP(float, WS_SIDE), (LAS float*)(F.lds + XCH_OFF), F.wave, 0};
            pg8::gemm_phase<EpiUpConv, StaticOrderRs, true, true>(F.lds, g, S, E, F.tid);
        } SEAM(p);
        if (IN(p + 1)) { ffn_fixup_pass(F, F.in[21] + (size_t)l * 3 * DFF); } SEAM(p + 1);
        if (IN(p + 2)) {
            pg8::Gemm g{WSP(bf16, WS_UP), WSP(bf16, WS_W_DOWN) + (size_t)l * 1024 * DFF, MTOK, 1024, DFF, DFF}; pg8::StaticOrder S; S.init(MTOK, 1024, F.G, (int)blockIdx.x);
            EpiRes E{F.out, F.out, WSP(bf16, WS_XS), MOD + l * 8 * 6144 + 5120, F.in[4] + 1024, MOD + 8 * 6144 + 1024, SSQ, l == 0 ? 1 : 0};
            pg8::gemm_phase<EpiRes, pg8::StaticOrder, true, true>(F.lds, g, S, E, F.tid);
        } SEAM(p + 2);
        if (l == 1) break;
        if (IN(10)) for (int rp_ = 0; rp_ < NREP(10); ++rp_) {
            pg8::Gemm g{WSP(bf16, WS_XS), WSP(bf16, WS_W_NSAIN), MTOK, NSAN, 1024, 1024}; StaticOrderRs S; S.init(MTOK, NSAN, F.G, (int)blockIdx.x); S.ssq = SSQ; S.tab = (LAS float*)(F.lds + RSTD_OFF); S.tid = F.tid; S.cnt = 0;
            EpiNsaIn E{(const LAS float*)(F.lds + RSTD_OFF), WSP(float, WS_BV_NSA), WSP(bf16, WS_QN), WSP(bf16, WS_KV6), WSP(float, WS_GATES), 0};
            pg8::gemm_phase<EpiNsaIn, StaticOrderRs, true, true>(F.lds, g, S, E, F.tid);
        } SEAM(10);
        if (IN(11)) for (int rp_ = 0; rp_ < NREP(11); ++rp_) {
#pragma unroll 1
            for (int which = 0; which < 2; ++which) {
                pg8::Gemm g{WSP(bf16, WS_KV6) + (size_t)which * BATCH * 4 * KVPANEL, WSP(bf16, WS_W_CMP1) + (size_t)which * 256 * 2048, 8192, 256, 2048, 1024};
                OffsetOrder S; S.init(8192, 256, F.G, (int)blockIdx.x, which * 32);
                EpiCmp1 E{WSP(float, WS_CMPB) + which * 256, WSP(bf16, WS_HID) + (size_t)which * 8192 * 256};
                pg8::gemm_phase<EpiCmp1, OffsetOrder, true, true>(F.lds, g, S, E, F.tid);
            }
        } SEAM(11);
        if (IN(12)) for (int rp_ = 0; rp_ < NREP(12); ++rp_) { cmp2_pass(F); } SEAM(12);
        if (IN(13)) for (int rp_ = 0; rp_ < NREP(13); ++rp_) { attn_phase(F); } SEAM(13);
        if (IN(14)) {
            pg8::Gemm g{WSP(bf16, WS_AO), WSP(bf16, WS_W_NSAOUT), MTOK, 1024, 1024, 1024}; pg8::StaticOrder S; S.init(MTOK, 1024, F.G, (int)blockIdx.x);
            EpiRes E{F.out, F.out, WSP(bf16, WS_XS), MOD + 8 * 6144 + 2048, F.in[5] + 1024, MOD + 8 * 6144 + 4096, SSQ, 1};
            pg8::gemm_phase<EpiRes, pg8::StaticOrder, true, true>(F.lds, g, S, E, F.tid);
        } SEAM(14);
    }
    if (IN(18)) { final_pass(F); }
#undef IN
#undef SEAM
}

#ifndef MK_SINGLE
#define MK_SINGLE 1
#endif
extern "C" void kernel_launch(void* const* d_in, const int* in_sizes, int n_in, void* d_out, int out_size, void* d_ws, size_t ws_size, hipStream_t stream) {
    static int grid = 0;
    if (grid == 0) {
        if (n_in != 24 || in_sizes[0] != MTOK * DM || out_size != MTOK * DM || ws_size < WS_END) { fprintf(stderr, "kernel_launch: unexpected shapes (n_in %d, in0 %d, out %d, ws %zu)\n", n_in, n_in > 0 ? in_sizes[0] : -1, out_size, ws_size); grid = -1; return; }
        int dev = 0, cus = 0, per_cu = 0;
        if (hipGetDevice(&dev) != hipSuccess || hipDeviceGetAttribute(&cus, hipDeviceAttributeMultiprocessorCount, dev) != hipSuccess) { grid = -1; return; }
        if (hipFuncSetAttribute((const void*)fwd_kernel, hipFuncAttributeMaxDynamicSharedMemorySize, LDS_BYTES) != hipSuccess) { fprintf(stderr, "kernel_launch: hipFuncSetAttribute failed\n"); grid = -1; return; }
        if (hipOccupancyMaxActiveBlocksPerMultiprocessor(&per_cu, (const void*)fwd_kernel, NTHR, LDS_BYTES) != hipSuccess || per_cu < 1) { fprintf(stderr, "kernel_launch: occupancy query gives %d\n", per_cu); per_cu = 1; }
        (void)hipGetLastError();
        grid = cus;
    }
    if (grid < 0) return;
    (void)hipMemsetAsync((char*)d_ws + WS_CTL, 0, CTL_ZERO_BYTES, stream);
    Args a{};
    for (int i = 0; i < 24; ++i) a.in[i] = (const float*)d_in[i];
    a.out = (float*)d_out; a.ws = (unsigned char*)d_ws;
#if MK_SINGLE
    a.ph_lo = 0; a.ph_hi = NPHASE; a.li = 0;
    void* kargs[] = {&a};
    hipError_t e = hipLaunchCooperativeKernel((const void*)fwd_kernel, dim3(grid), dim3(NTHR), kargs, LDS_BYTES, stream);
    if (e != hipSuccess) fprintf(stderr, "kernel_launch: cooperative launch failed: %s (grid %d)\n", hipGetErrorString(e), grid);
#else
    for (int p = 0; p < NPHASE; ++p) { a.ph_lo = p; a.ph_hi = p + 1; a.li = p; hipLaunchKernelGGL(fwd_kernel, dim3(grid), dim3(NTHR), LDS_BYTES, stream, a); }
#endif
}
```
